# Optimizing an MI355X kernel written in HIP

```python
import jax, jax.numpy as jnp
from jax import lax
import numpy as np

D_MODEL = 1024
BATCH = 32
SEQ = 256
DEPTH = 4
DEC_BATCH = 8
DEC_SEQ = 4096
PAST_LEN = 512

N_HEADS = 16
N_KV_HEADS = 4
HEAD_DIM = D_MODEL // N_HEADS
KV_GROUP = N_HEADS // N_KV_HEADS
D_FF = 2816
GRID_W = 64
Q_BLOCK = 128
WINDOW = 128
ROPE_FREQS = HEAD_DIM // 4
ROPE_THETA = 10000.0
N_MOD = 9
N_MIXERS = 2
ATTN_SCALE = HEAD_DIM ** -0.5
EPS = 1e-6
NEG_INF = -1e30

kernel_name = "hybrid_dit_prefix_gqa_swa_macaron_step"


def _rmsnorm(x, g):
    xf = x.astype(jnp.float32)
    y = xf * lax.rsqrt(jnp.mean(xf * xf, axis=-1, keepdims=True) + EPS)
    return (y * g.astype(jnp.float32)).astype(x.dtype)


def _modulation(cond, w, b):
    m = jax.nn.silu(cond) @ w + b
    return jnp.split(m[:, None, :], N_MOD, axis=-1)


def _modln(h, g, shift, scale):
    return _rmsnorm(h, g) * (1 + scale) + shift


def _swiglu(x, w_in, w_out):
    gate, up = jnp.split(x @ w_in, 2, axis=-1)
    return (jax.nn.silu(gate) * up) @ w_out


def _qkv(a, w_qkv, qg, kg):
    b, l, _ = a.shape
    proj = a @ w_qkv
    q, k, v = jnp.split(proj, [N_HEADS * HEAD_DIM, (N_HEADS + N_KV_HEADS) * HEAD_DIM], axis=-1)
    q = _rmsnorm(q.reshape(b, l, N_HEADS, HEAD_DIM), qg)
    k = _rmsnorm(k.reshape(b, l, N_KV_HEADS, HEAD_DIM), kg)
    v = v.reshape(b, l, N_KV_HEADS, HEAD_DIM)
    return q, k, v


def _axial_rope(x):
    n_tok = x.shape[1]
    rows = n_tok // GRID_W
    row = jnp.repeat(jnp.arange(rows), GRID_W).astype(jnp.float32)
    col = jnp.tile(jnp.arange(GRID_W), rows).astype(jnp.float32)
    freqs = 1.0 / jnp.power(ROPE_THETA, jnp.arange(ROPE_FREQS, dtype=jnp.float32) / ROPE_FREQS)
    ang = jnp.stack([row[:, None] * freqs, col[:, None] * freqs], axis=1)
    cos = jnp.cos(ang)[:, None]
    sin = jnp.sin(ang)[:, None]
    xf = x.astype(jnp.float32).reshape(x.shape[:-1] + (2, 2, ROPE_FREQS))
    x1, x2 = xf[..., 0, :], xf[..., 1, :]
    out = jnp.stack([x1 * cos - x2 * sin, x2 * cos + x1 * sin], axis=-2)
    return out.reshape(x.shape).astype(x.dtype)


def _softmax_sink(s, sink):
    if sink is None:
        return jax.nn.softmax(s, axis=-1)
    sk = sink.astype(jnp.float32).reshape(N_KV_HEADS, KV_GROUP)[None, :, :, None, None]
    m = jnp.maximum(jnp.max(s, axis=-1, keepdims=True), sk)
    e = jnp.exp(s - m)
    return e / (jnp.sum(e, axis=-1, keepdims=True) + jnp.exp(sk - m))


def _attend_blocks(q, k, v, sink):
    b, lq, h, d = q.shape
    nb = lq // Q_BLOCK
    qb = q.reshape(b, nb, Q_BLOCK, N_KV_HEADS, KV_GROUP, d).transpose(1, 0, 2, 3, 4, 5)

    def one(qi):
        s = jnp.einsum("bqkgd,bskd->bkgqs", qi, k, preferred_element_type=jnp.float32) * ATTN_SCALE
        p = _softmax_sink(s, sink)
        o = jnp.einsum("bkgqs,bskd->bqkgd", p.astype(v.dtype), v)
        return o.reshape(b, Q_BLOCK, h, d)

    o = lax.map(one, qb)
    return o.transpose(1, 0, 2, 3, 4).reshape(b, lq, h, d)


def _attend_window(q, k_lat, v_lat, k_ctx, v_ctx, sink):
    b, l, h, d = q.shape
    nb = l // Q_BLOCK
    band = Q_BLOCK + 2 * WINDOW
    c_len = k_ctx.shape[1]
    pad = ((0, 0), (WINDOW, WINDOW), (0, 0), (0, 0))
    kp = jnp.pad(k_lat, pad)
    vp = jnp.pad(v_lat, pad)
    qb = q.reshape(b, nb, Q_BLOCK, N_KV_HEADS, KV_GROUP, d).transpose(1, 0, 2, 3, 4, 5)

    def one(args):
        qi, bi = args
        start = bi * Q_BLOCK
        kb = lax.dynamic_slice_in_dim(kp, start, band, axis=1)
        vb = lax.dynamic_slice_in_dim(vp, start, band, axis=1)
        s_band = jnp.einsum("bqkgd,bskd->bkgqs", qi, kb, preferred_element_type=jnp.float32) * ATTN_SCALE
        qpos = start + jnp.arange(Q_BLOCK)
        kpos = start - WINDOW + jnp.arange(band)
        valid = (jnp.abs(qpos[:, None] - kpos[None, :]) <= WINDOW) & (kpos >= 0)[None, :] & (kpos < l)[None, :]
        s_band = jnp.where(valid, s_band, NEG_INF)
        s_ctx = jnp.einsum("bqkgd,bskd->bkgqs", qi, k_ctx, preferred_element_type=jnp.float32) * ATTN_SCALE
        p = _softmax_sink(jnp.concatenate([s_ctx, s_band], axis=-1), sink).astype(v_lat.dtype)
        o = (jnp.einsum("bkgqs,bskd->bqkgd", p[..., :c_len], v_ctx)
             + jnp.einsum("bkgqs,bskd->bqkgd", p[..., c_len:], vb))
        return o.reshape(b, Q_BLOCK, h, d)

    o = lax.map(one, (qb, jnp.arange(nb)))
    return o.transpose(1, 0, 2, 3, 4).reshape(b, l, h, d)


def _macaron_layer(h, mods, norm_g_i, w_in_i, w_out_i, mix):
    sh1, sc1, g1, sh2, sc2, g2, sh3, sc3, g3 = mods
    h = h + 0.5 * g1 * _swiglu(_modln(h, norm_g_i[0], sh1, sc1), w_in_i[0], w_out_i[0])
    out, aux = mix(_modln(h, norm_g_i[1], sh2, sc2))
    h = h + g2 * out
    h = h + 0.5 * g3 * _swiglu(_modln(h, norm_g_i[2], sh3, sc3), w_in_i[1], w_out_i[1])
    return h, aux


def setup_inputs(seed: int = 0) -> dict:
    key = jax.random.key(seed)
    ks = jax.random.split(key, 16)
    f32 = jnp.float32

    def nrm(k, shape, scale):
        return jax.random.normal(k, shape, f32) * scale

    n_win = DEPTH // N_MIXERS
    qkv_cols = (N_HEADS + 2 * N_KV_HEADS) * HEAD_DIM
    kv_shape = (DEC_BATCH, DEPTH, PAST_LEN, N_KV_HEADS, HEAD_DIM)
    return {
        "x_prompt": nrm(ks[0], (BATCH, SEQ, D_MODEL), 1.0),
        "x_sample": nrm(ks[1], (DEC_BATCH, DEC_SEQ, D_MODEL), 1.0),
        "cache_k": nrm(ks[2], kv_shape, 1.0),
        "cache_v": nrm(ks[3], kv_shape, 1.0),
        "c": nrm(ks[4], (DEC_BATCH, D_MODEL), 1.0),
        "c_ctx": nrm(ks[5], (D_MODEL,), 1.0),
        "w_mod": nrm(ks[6], (DEPTH, D_MODEL, N_MOD * D_MODEL), 0.5 * D_MODEL ** -0.5),
        "b_mod": nrm(ks[7], (DEPTH, N_MOD * D_MODEL), 0.01),
        "norm_g": 1.0 + nrm(ks[8], (DEPTH, 3, D_MODEL), 0.02),
        "w_qkv": nrm(ks[9], (DEPTH, D_MODEL, qkv_cols), D_MODEL ** -0.5),
        "w_o": nrm(ks[10], (DEPTH, N_HEADS * HEAD_DIM, D_MODEL), (N_HEADS * HEAD_DIM) ** -0.5),
        "q_norm_g": 1.0 + nrm(ks[11], (DEPTH, HEAD_DIM), 0.02),
        "k_norm_g": 1.0 + nrm(ks[12], (DEPTH, HEAD_DIM), 0.02),
        "sink": nrm(ks[13], (n_win, N_HEADS), 0.5),
        "w_ffn_in": nrm(ks[14], (DEPTH, 2, D_MODEL, 2 * D_FF), D_MODEL ** -0.5),
        "w_ffn_out": nrm(ks[15], (DEPTH, 2, D_FF, D_MODEL), D_FF ** -0.5),
    }


def reference(x_prompt, x_sample, cache_k, cache_v, c, c_ctx, w_mod, b_mod, norm_g, w_qkv, w_o,
              q_norm_g, k_norm_g, sink, w_ffn_in, w_ffn_out):
    h = x_prompt
    bp, lp, _ = x_prompt.shape
    new_ks, new_vs = [], []
    for i in range(DEPTH):
        sink_i = sink[i // N_MIXERS] if i % N_MIXERS == 1 else None
        mods = _modulation(c_ctx[None, :], w_mod[i], b_mod[i])

        def mix_ctx(a, i=i, sink_i=sink_i):
            q, k, v = _qkv(a, w_qkv[i], q_norm_g[i], k_norm_g[i])
            o = _attend_blocks(q, k, v, sink_i)
            return o.reshape(bp, lp, N_HEADS * HEAD_DIM) @ w_o[i], (k, v)

        h, (k_i, v_i) = _macaron_layer(h, mods, norm_g[i], w_ffn_in[i], w_ffn_out[i], mix_ctx)
        new_ks.append(k_i)
        new_vs.append(v_i)
    y_prompt = h
    new_k = jnp.stack(new_ks, axis=1)
    new_v = jnp.stack(new_vs, axis=1)

    h = x_sample
    bs, ls, _ = x_sample.shape
    for i in range(DEPTH):
        mods = _modulation(c, w_mod[i], b_mod[i])
        ck = cache_k[:, i]
        cv = cache_v[:, i]

        def mix_lat(a, i=i, ck=ck, cv=cv):
            q, k, v = _qkv(a, w_qkv[i], q_norm_g[i], k_norm_g[i])
            q = _axial_rope(q)
            k = _axial_rope(k)
            if i % N_MIXERS == 0:
                o = _attend_blocks(q, jnp.concatenate([ck, k], axis=1), jnp.concatenate([cv, v], axis=1), None)
            else:
                o = _attend_window(q, k, v, ck, cv, sink[i // N_MIXERS])
            return o.reshape(bs, ls, N_HEADS * HEAD_DIM) @ w_o[i], None

        h, _ = _macaron_layer(h, mods, norm_g[i], w_ffn_in[i], w_ffn_out[i], mix_lat)
    y_sample = h

    return (y_prompt, y_sample, new_k, new_v)
```

```cpp
#include <hip/hip_runtime.h>
#include <hip/hip_cooperative_groups.h>
#include <cstdio>
#include <cstdint>
#include <cmath>
#include <type_traits>
namespace cg = cooperative_groups;
namespace pg8 {
#define PG8_LAS __attribute__((address_space(3)))
typedef unsigned short bf16_t;
typedef short bf16x8 __attribute__((ext_vector_type(8)));
typedef float f32x4 __attribute__((ext_vector_type(4)));
typedef unsigned u32x4 __attribute__((ext_vector_type(4)));
constexpr int BM = 256, BK = 64, HALF = 128, HTB = HALF * BK * 2  , STAGE_BYTES = 8 * HTB, NXCD = 8, WGM = 8;

__host__ __device__ __forceinline__ int lds_byte(int r, int c) { const int st = (r >> 4) * 2 + (c >> 5), rr = r & 15, cc = c & 31, ob = rr * 64 + cc * 2; return st * 1024 + (ob ^ (((ob >> 9) & 1) << 5)); }
__host__ __device__ __forceinline__ void stage_rc(int b, int& R, int& C) { const int st = b / 1024, sb = b % 1024, swz = sb ^ (((sb >> 9) & 1) << 5); R = (st >> 1) * 16 + swz / 64; C = (st & 1) * 32 + (swz % 64) / 2; }
__host__ __device__ __forceinline__ int perm32(int rho) { const int n = rho >> 4, i = rho & 15; return 8 * (i >> 2) + 4 * n + (i & 3); }

struct Unit { int pm, pn; };
struct Gemm { const bf16_t* A; const bf16_t* Bt; int M, N, K; };

struct StaticOrder {
    int nM, nN, nwg, G, c;
    __host__ __device__ void init(int M, int N, int G_, int c_) { nM = M / BM; nN = N / BM; nwg = nM * nN; G = G_; c = c_; }
    __host__ __device__ bool next(int i, Unit& u) const {
        const long L = (long)i * G + c; if (L >= nwg) return false;
        int wgid = (int)L; { const int q = nwg / NXCD, r = nwg % NXCD, xcd = wgid % NXCD, off = wgid / NXCD; wgid = (xcd < r ? xcd * (q + 1) : r * (q + 1) + (xcd - r) * q) + off; }
        const int nig = WGM * nN, gid = wgid / nig, fm = gid * WGM, gsz = (nM - fm) < WGM ? (nM - fm) : WGM;
        u.pm = fm + ((wgid % nig) % gsz); u.pn = (wgid % nig) / gsz; return true;
    }
    __device__ __forceinline__ void a_ready(const Unit&) const {}
    __device__ __forceinline__ void done(const Unit&) const {}
};

__device__ __forceinline__ unsigned cvt_pk_bf16(float lo, float hi) { unsigned r; asm volatile("v_cvt_pk_bf16_f32 %0, %1, %2" : "=v"(r) : "v"(lo), "v"(hi)); return r; }
constexpr int E_DM = 1024, E_DFF = 2816, E_MP = 8192;
__device__ __forceinline__ float silu_f(float g) { return g * __builtin_amdgcn_rcpf(1.0f + __builtin_amdgcn_exp2f(-1.4426950408889634f * g)); }

struct EpiSwiglu {
    static constexpr bool PERM = true, AFTER_DRAIN = false;
    bf16_t* H;
    __device__ __forceinline__ void operator()(const f32x4 (&acc)[2][2][4][2], const Unit& u, int wr, int wc, int fr_, int fq_) const {
        int fr = fr_, fq = fq_; asm volatile("" : "+v"(fr), "+v"(fq));
        const int row0 = u.pm * BM + wr * 64 + fr; const int col0 = u.pn * 128 + wc * 32 + 8 * fq;
#pragma unroll
        for (int ai = 0; ai < 2; ++ai)
#pragma unroll
            for (int m = 0; m < 4; ++m) {
                bf16_t* rowp = H + (size_t)(row0 + ai * HALF + m * 16) * E_DFF + col0;
                const f32x4 g0 = acc[ai][0][m][0], g1 = acc[ai][0][m][1], u0 = acc[ai][1][m][0], u1 = acc[ai][1][m][1];
                u32x4 w;
                w.x = cvt_pk_bf16(silu_f(g0[0]) * u0[0], silu_f(g0[1]) * u0[1]); w.y = cvt_pk_bf16(silu_f(g0[2]) * u0[2], silu_f(g0[3]) * u0[3]);
                w.z = cvt_pk_bf16(silu_f(g1[0]) * u1[0], silu_f(g1[1]) * u1[1]); w.w = cvt_pk_bf16(silu_f(g1[2]) * u1[2], silu_f(g1[3]) * u1[3]);
                *(u32x4*)rowp = w;
            }
    }
};

typedef _Float16 h16x2 __attribute__((ext_vector_type(2)));
__device__ __forceinline__ unsigned pack_h2(float lo, float hi) { h16x2 r; r.x = (_Float16)__builtin_amdgcn_fmed3f(lo, -65504.f, 65504.f); r.y = (_Float16)__builtin_amdgcn_fmed3f(hi, -65504.f, 65504.f); return __builtin_bit_cast(unsigned, r); }
__device__ __forceinline__ float h2_lo(unsigned w) { return (float)__builtin_bit_cast(h16x2, w).x; }
__device__ __forceinline__ float h2_hi(unsigned w) { return (float)__builtin_bit_cast(h16x2, w).y; }
struct EpiResid {
    static constexpr bool PERM = true, AFTER_DRAIN = false;
    const float* xin; long long hi_adj; bf16_t* hb; float* outf; const float* mods_l; int gate_off; float coef;
    __device__ __forceinline__ void operator()(const f32x4 (&acc)[2][2][4][2], const Unit& u, int wr, int wc, int fr_, int fq_) const {
        int fr = fr_, fq = fq_; asm volatile("" : "+v"(fr), "+v"(fq));
        const int rowt = u.pm * BM; const int cond = rowt < E_MP ? 0 : 1 + ((rowt - E_MP) >> 12);
        const float* gp = mods_l + cond * 9216 + gate_off;
        const int col0 = u.pn * BM + wc * 32 + 8 * fq;
        f32x4 gv[2][2];
#pragma unroll
        for (int bj = 0; bj < 2; ++bj)
#pragma unroll
            for (int n = 0; n < 2; ++n) gv[bj][n] = *(const f32x4*)(gp + col0 + bj * HALF + n * 4) * coef;
        if (xin) {
            const float* base = xin + (rowt < E_MP ? 0ll : hi_adj) + (size_t)rowt * E_DM;
#pragma unroll
            for (int ai = 0; ai < 2; ++ai)
#pragma unroll
                for (int m = 0; m < 4; ++m) { const size_t off = (size_t)(ai * HALF + wr * 64 + m * 16 + fr) * E_DM + col0;
#pragma unroll
                    for (int bj = 0; bj < 2; ++bj) { const f32x4 b0 = *(const f32x4*)(base + off + bj * HALF), b1 = *(const f32x4*)(base + off + bj * HALF + 4);
                        const f32x4 y0 = b0 + gv[bj][0] * acc[ai][bj][m][0], y1 = b1 + gv[bj][1] * acc[ai][bj][m][1];
                        u32x4 w; w.x = pack_h2(y0[0], y0[1]); w.y = pack_h2(y0[2], y0[3]); w.z = pack_h2(y1[0], y1[1]); w.w = pack_h2(y1[2], y1[3]);
                        *(u32x4*)(hb + (size_t)rowt * E_DM + off + bj * HALF) = w; }
                    if (m & 1) asm volatile("" ::: "memory"); }
        } else {
            bf16_t* hp = hb + (size_t)rowt * E_DM;
#pragma unroll
            for (int ai = 0; ai < 2; ++ai) {
                u32x4 b[4][2];
#pragma unroll
                for (int m = 0; m < 4; ++m) { const size_t off = (size_t)(ai * HALF + wr * 64 + m * 16 + fr) * E_DM + col0;
#pragma unroll
                    for (int bj = 0; bj < 2; ++bj) b[m][bj] = *(const u32x4*)(hp + off + bj * HALF); }
#pragma unroll
                for (int m = 0; m < 4; ++m) { const size_t off = (size_t)(ai * HALF + wr * 64 + m * 16 + fr) * E_DM + col0;
#pragma unroll
                    for (int bj = 0; bj < 2; ++bj) { const u32x4 q = b[m][bj];
                        const f32x4 b0 = (f32x4){h2_lo(q.x), h2_hi(q.x), h2_lo(q.y), h2_hi(q.y)};
                        const f32x4 b1 = (f32x4){h2_lo(q.z), h2_hi(q.z), h2_lo(q.w), h2_hi(q.w)};
                        const f32x4 y0 = b0 + gv[bj][0] * acc[ai][bj][m][0], y1 = b1 + gv[bj][1] * acc[ai][bj][m][1];
                        if (outf) { float* o = outf + (size_t)rowt * E_DM + off + bj * HALF; *(f32x4*)o = y0; *(f32x4*)(o + 4) = y1; }
                        else { u32x4 w; w.x = pack_h2(y0[0], y0[1]); w.y = pack_h2(y0[2], y0[3]); w.z = pack_h2(y1[0], y1[1]); w.w = pack_h2(y1[2], y1[3]); *(u32x4*)(hp + off + bj * HALF) = w; } } }
                asm volatile("" ::: "memory"); }
        }
    }
};

struct EpiQKV {
    static constexpr bool PERM = false, AFTER_DRAIN = false;
    static constexpr long long KOFF = 80ll * 1048576 / 2, VOFF = 100ll * 1048576 / 2, NVOFF = 8388608ll;
    bf16_t* Q; float* newk; const float* qg; const float* kg; const float* ropec; float qscale;
    __device__ __forceinline__ void operator()(const f32x4 (&acc)[2][2][4][2], const Unit& u, int wr, int wc, int fr_, int fq_) const {
        int fr = fr_, fq = fq_; asm volatile("" : "+v"(fr), "+v"(fq));
        const int rowt = u.pm * BM; const bool lat = rowt >= E_MP; const int pn = u.pn;
        f32x4 gv[2][2];
#pragma unroll
        for (int bj = 0; bj < 2; ++bj)
#pragma unroll
            for (int n = 0; n < 2; ++n) { const f32x4 a = *(const f32x4*)(qg + 32 * bj + 16 * n + 4 * fq) * qscale, b = *(const f32x4*)(kg + 32 * bj + 16 * n + 4 * fq);
                gv[bj][n] = pn < 4 ? a : b; }
        const long long kvoff = pn == 4 ? KOFF : VOFF; const long long nkoff = pn == 4 ? 0ll : NVOFF;
#pragma unroll
        for (int ai = 0; ai < 2; ++ai)
#pragma unroll
            for (int m = 0; m < 4; ++m) {
                const int r = rowt + ai * HALF + wr * 64 + m * 16 + fr;
                f32x4 v[2][2];
#pragma unroll
                for (int bj = 0; bj < 2; ++bj)
#pragma unroll
                    for (int n = 0; n < 2; ++n) v[bj][n] = acc[ai][bj][m][n];
                if (pn < 5) {
                    float ss = 0.f;
#pragma unroll
                    for (int bj = 0; bj < 2; ++bj)
#pragma unroll
                        for (int n = 0; n < 2; ++n) { const f32x4 x = v[bj][n]; ss += (x[0] * x[0] + x[1] * x[1]) + (x[2] * x[2] + x[3] * x[3]); }
                    ss += __shfl_xor(ss, 16); ss += __shfl_xor(ss, 32);
                    const float rstd = __builtin_amdgcn_rsqf(ss * (1.0f / 64.0f) + 1e-6f);
#pragma unroll
                    for (int bj = 0; bj < 2; ++bj)
#pragma unroll
                        for (int n = 0; n < 2; ++n) v[bj][n] = v[bj][n] * rstd * gv[bj][n];
                }
                if (!lat && pn >= 4) {
                    float* dst = newk + nkoff + (size_t)(r >> 8) * (4 * 65536) + (size_t)(r & 255) * 256 + wc * 64 + 4 * fq;
#pragma unroll
                    for (int bj = 0; bj < 2; ++bj)
#pragma unroll
                        for (int n = 0; n < 2; ++n) *(f32x4*)(dst + 32 * bj + 16 * n) = v[bj][n];
                }
                if (lat && pn < 5) {
                    const int t = (r - E_MP) & 4095;
#pragma unroll
                    for (int bj = 0; bj < 2; ++bj) { const int pos = bj ? (t & 63) : (t >> 6);
                        const f32x4 cs = *(const f32x4*)(ropec + pos * 16 + 4 * fq), sn = *(const f32x4*)(ropec + 1024 + pos * 16 + 4 * fq);
                        const f32x4 x1 = v[bj][0], x2 = v[bj][1]; v[bj][0] = x1 * cs - x2 * sn; v[bj][1] = x2 * cs + x1 * sn; }
                }
                const long long doff = (pn < 4) ? (long long)r * 1024 + (4 * pn + wc) * 64 : kvoff + (long long)r * 256 + wc * 64;
                bf16_t* dst = Q + doff + 4 * fq;
#pragma unroll
                for (int bj = 0; bj < 2; ++bj)
#pragma unroll
                    for (int n = 0; n < 2; ++n) { typedef unsigned u32x2 __attribute__((ext_vector_type(2))); u32x2 w; w.x = cvt_pk_bf16(v[bj][n][0], v[bj][n][1]); w.y = cvt_pk_bf16(v[bj][n][2], v[bj][n][3]);
                        *(u32x2*)(dst + 32 * bj + 16 * n) = w; }
                asm volatile("" ::: "memory");
            }
    }
};
template <class Epi, class Sched, bool ALIGN_EPI = false, bool SP2 = false>
__device__ __forceinline__ void gemm_phase(PG8_LAS unsigned char* lds, const Gemm g, const Sched& S, const Epi& E, const int tid) {
    const int wid = __builtin_amdgcn_readfirstlane(tid >> 6), lane = tid & 63, wr = wid >> 2, wc = wid & 3, fr = lane & 15, fq = lane >> 4;
    const int K = g.K, nt = K / BK;
    unsigned voffA[2], voffB[2];
#pragma unroll
    for (int i = 0; i < 2; ++i) { int R, C; stage_rc(tid * 16 + i * 8192, R, C); const int Rb = Epi::PERM ? ((R & ~31) + perm32(R & 31)) : R;
        voffA[i] = (unsigned)(R * K + C) * 2u; voffB[i] = (unsigned)(Rb * K + C) * 2u; }
    const size_t kstep = (size_t)(BK * 2);
    const size_t hstep = (size_t)HALF * K * 2;
    const size_t tstep = 2 * hstep;
    const unsigned ldsw = (unsigned)wid * 1024u;
    const int aoff = lds_byte(wr * 64 + fr, fq * 8), boff = lds_byte(wc * 32 + fr, fq * 8);
#define PG8_SA(b, h) (((b) * 2 + (h)) * HTB)
#define PG8_SB(b, h) ((4 + (b) * 2 + (h)) * HTB)
#define PG8_STAGE(bufoff, gbase, voff) do { _Pragma("unroll") for (int _i = 0; _i < 2; ++_i) \
        __builtin_amdgcn_global_load_lds((const unsigned*)((const char*)(gbase) + (voff)[_i]), (PG8_LAS unsigned*)(lds + (bufoff) + ldsw + _i * 8192), 16, 0, 0); } while (0)
#define PG8_LDA(dst, b, h) do { _Pragma("unroll") for (int m = 0; m < 4; ++m) _Pragma("unroll") for (int k = 0; k < 2; ++k) dst[m][k] = *(const PG8_LAS bf16x8*)(lds + PG8_SA(b, h) + aoff + m * 2048 + k * 1024); } while (0)
#define PG8_LDB(dst, b, h) do { _Pragma("unroll") for (int n = 0; n < 2; ++n) _Pragma("unroll") for (int k = 0; k < 2; ++k) dst[n][k] = *(const PG8_LAS bf16x8*)(lds + PG8_SB(b, h) + boff + n * 2048 + k * 1024); } while (0)
#define PG8_MMA(ai, bj, At, Bt) do { __builtin_amdgcn_s_setprio(1); _Pragma("unroll") for (int m = 0; m < 4; ++m) _Pragma("unroll") for (int n = 0; n < 2; ++n) _Pragma("unroll") for (int k = 0; k < 2; ++k) \
        acc[ai][bj][m][n] = __builtin_amdgcn_mfma_f32_16x16x32_bf16(Bt[n][k], At[m][k], acc[ai][bj][m][n], 0, 0, 0); __builtin_amdgcn_s_setprio(0); } while (0)
#define PG8_WAIT_V(n) asm volatile("s_waitcnt vmcnt(" #n ")" ::: "memory")
#define PG8_WAIT_L(n) asm volatile("s_waitcnt lgkmcnt(" #n ")" ::: "memory")
#define PG8_BAR __builtin_amdgcn_s_barrier()
#define PG8_SCHED __builtin_amdgcn_sched_barrier(0)
    Unit cur, nxt; int ui = 0;
    if (!S.next(0, cur)) return;
    f32x4 acc[2][2][4][2];
#pragma unroll
    for (int a = 0; a < 2; ++a)
#pragma unroll
        for (int b = 0; b < 2; ++b)
#pragma unroll
            for (int m = 0; m < 4; ++m)
#pragma unroll
                for (int n = 0; n < 2; ++n) acc[a][b][m][n] = (f32x4){0.f, 0.f, 0.f, 0.f};
    bf16x8 At[4][2], B0[2][2], B1[2][2];
    const char* cA = (const char*)g.A + (size_t)cur.pm * tstep; const char* cB = (const char*)g.Bt + (size_t)cur.pn * tstep;
    S.a_ready(cur);
    if constexpr (SP2) {
        PG8_STAGE(PG8_SB(0, 0), cB, voffB); PG8_STAGE(PG8_SB(0, 1), cB + hstep, voffB); PG8_STAGE(PG8_SA(0, 0), cA, voffA); PG8_STAGE(PG8_SA(0, 1), cA + hstep, voffA);
        if (wr == 1) PG8_BAR;
        PG8_WAIT_V(2); PG8_BAR;
        PG8_STAGE(PG8_SB(1, 0), cB + kstep, voffB); PG8_STAGE(PG8_SA(1, 0), cA + kstep, voffA); PG8_STAGE(PG8_SB(1, 1), cB + hstep + kstep, voffB);
        PG8_WAIT_V(6); PG8_BAR;
    } else {
        PG8_STAGE(PG8_SB(0, 0), cB, voffB); PG8_STAGE(PG8_SA(0, 0), cA, voffA); PG8_STAGE(PG8_SB(0, 1), cB + hstep, voffB); PG8_STAGE(PG8_SA(0, 1), cA + hstep, voffA);
        if (wr == 1) PG8_BAR;
        PG8_WAIT_V(4); PG8_BAR;
        PG8_STAGE(PG8_SB(1, 0), cB + kstep, voffB); PG8_STAGE(PG8_SA(1, 0), cA + kstep, voffA); PG8_STAGE(PG8_SB(1, 1), cB + hstep + kstep, voffB);
        PG8_WAIT_V(6); PG8_BAR;
    }
    for (;;) {
        const bool has_next = S.next(ui + 1, nxt);
        const char* nA = has_next ? (const char*)g.A + (size_t)nxt.pm * tstep : cA; const char* nB = has_next ? (const char*)g.Bt + (size_t)nxt.pn * tstep : cB;
        for (int t = 0; t < nt; t += 2) {
            const bool last = (t == nt - 2);
            const char* a1 = cA + (size_t)(t + 1) * kstep;
            const char* a2 = last ? nA : cA + (size_t)(t + 2) * kstep; const char* b2 = last ? nB : cB + (size_t)(t + 2) * kstep;
            const char* a3 = a2 + kstep; const char* b3 = b2 + kstep;
            if (last && has_next) S.a_ready(nxt);
            if constexpr (SP2) {
            PG8_LDB(B0, 0, 0); PG8_LDB(B1, 0, 1); PG8_SCHED; PG8_LDA(At, 0, 0); PG8_STAGE(PG8_SA(1, 1), a1 + hstep, voffA);
            PG8_WAIT_V(8); PG8_WAIT_L(0); PG8_BAR; PG8_MMA(0, 0, At, B0); PG8_MMA(0, 1, At, B1); PG8_BAR; PG8_SCHED;
            PG8_LDA(At, 0, 1); PG8_STAGE(PG8_SB(0, 0), b2, voffB); PG8_STAGE(PG8_SB(0, 1), b2 + hstep, voffB); PG8_STAGE(PG8_SA(0, 0), a2, voffA);
            PG8_WAIT_V(8); PG8_WAIT_L(0); PG8_BAR; PG8_MMA(1, 0, At, B0); PG8_MMA(1, 1, At, B1); PG8_BAR; PG8_SCHED;
            PG8_LDB(B0, 1, 0); PG8_LDB(B1, 1, 1); PG8_SCHED; PG8_LDA(At, 1, 0); PG8_STAGE(PG8_SA(0, 1), a2 + hstep, voffA);
            PG8_WAIT_V(8); PG8_WAIT_L(0); PG8_BAR; PG8_MMA(0, 0, At, B0); PG8_MMA(0, 1, At, B1); PG8_BAR; PG8_SCHED;
            PG8_LDA(At, 1, 1); PG8_STAGE(PG8_SB(1, 0), b3, voffB); PG8_STAGE(PG8_SB(1, 1), b3 + hstep, voffB); PG8_STAGE(PG8_SA(1, 0), a3, voffA);
            PG8_WAIT_V(8); PG8_WAIT_L(0); PG8_BAR; PG8_MMA(1, 0, At, B0); PG8_MMA(1, 1, At, B1); PG8_BAR; PG8_SCHED;
            } else {
            PG8_LDB(B0, 0, 0); PG8_SCHED; PG8_LDA(At, 0, 0); PG8_STAGE(PG8_SA(1, 1), a1 + hstep, voffA);
            PG8_WAIT_L(8); PG8_BAR; PG8_WAIT_L(0); PG8_MMA(0, 0, At, B0); PG8_BAR; PG8_SCHED;
            PG8_LDB(B1, 0, 1); PG8_STAGE(PG8_SB(0, 0), b2, voffB);
            PG8_BAR; PG8_WAIT_L(0); PG8_MMA(0, 1, At, B1); PG8_BAR;
            PG8_LDA(At, 0, 1); PG8_STAGE(PG8_SA(0, 0), a2, voffA);
            PG8_BAR; PG8_WAIT_L(0); PG8_MMA(1, 0, At, B0); PG8_BAR; PG8_SCHED;
            PG8_STAGE(PG8_SB(0, 1), b2 + hstep, voffB);
            PG8_WAIT_V(6); PG8_BAR; PG8_MMA(1, 1, At, B1); PG8_BAR;
            PG8_LDB(B0, 1, 0); PG8_SCHED; PG8_LDA(At, 1, 0); PG8_STAGE(PG8_SA(0, 1), a2 + hstep, voffA);
            PG8_WAIT_L(8); PG8_BAR; PG8_WAIT_L(0); PG8_MMA(0, 0, At, B0); PG8_BAR; PG8_SCHED;
            PG8_LDB(B1, 1, 1); PG8_STAGE(PG8_SB(1, 0), b3, voffB);
            PG8_BAR; PG8_WAIT_L(0); PG8_MMA(0, 1, At, B1); PG8_BAR;
            PG8_LDA(At, 1, 1); PG8_STAGE(PG8_SA(1, 0), a3, voffA);
            PG8_BAR; PG8_WAIT_L(0); PG8_MMA(1, 0, At, B0); PG8_BAR; PG8_SCHED;
            PG8_STAGE(PG8_SB(1, 1), b3 + hstep, voffB);
            PG8_WAIT_V(6); PG8_BAR; PG8_MMA(1, 1, At, B1); PG8_BAR;
            }
        }
        if constexpr (ALIGN_EPI) { if (wr == 0) PG8_BAR; }
        if constexpr (!Epi::AFTER_DRAIN) { E(acc, cur, wr, wc, fr, fq); S.done(cur); }
        if (!has_next) break;
#pragma unroll
        for (int a = 0; a < 2; ++a)
#pragma unroll
            for (int b = 0; b < 2; ++b)
#pragma unroll
                for (int m = 0; m < 4; ++m)
#pragma unroll
                    for (int n = 0; n < 2; ++n) acc[a][b][m][n] = (f32x4){0.f, 0.f, 0.f, 0.f};
        cur = nxt; cA = nA; cB = nB; ++ui;
        if constexpr (ALIGN_EPI) { if (wr == 1) PG8_BAR; }
    }
    PG8_WAIT_V(0);
    if constexpr (!ALIGN_EPI) { if (wr == 0) PG8_BAR; }
    PG8_BAR;
    if constexpr (Epi::AFTER_DRAIN) { E.fused(acc, cur, wr, wc, fr, fq, lds, wid, lane); S.done(cur); }
#undef PG8_SA
#undef PG8_SB
#undef PG8_STAGE
#undef PG8_LDA
#undef PG8_LDB
#undef PG8_MMA
#undef PG8_WAIT_V
#undef PG8_WAIT_L
#undef PG8_BAR
#undef PG8_SCHED
}
}
#define LAS __attribute__((address_space(3)))
typedef unsigned short bf16;
typedef unsigned v4u __attribute__((ext_vector_type(4)));
typedef unsigned v2u __attribute__((ext_vector_type(2)));
typedef float f32x4 __attribute__((ext_vector_type(4)));
typedef float f32x16 __attribute__((ext_vector_type(16)));
typedef short bf16x8 __attribute__((ext_vector_type(8)));
typedef short s16x4 __attribute__((ext_vector_type(4)));

constexpr int DM = 1024, NH = 16, NKV = 4, HD = 64, DFF = 2816, DEPTH = 4, NQKV = 1536;
constexpr int MP = 8192, MS = 32768, MT = 40960, LSEQ = 4096, PAST = 512, CSEQ = 256;
constexpr int NMODS = 9216;
constexpr size_t MiB = 1u << 20;
constexpr size_t WS_CKMAX = 15360;
constexpr size_t WS_MODS = 1 * MiB, WS_ROPE = 3 * MiB, WS_WQKV = 4 * MiB, WS_WO = 16 * MiB, WS_W1 = 24 * MiB, WS_W2 = 112 * MiB,
                 WS_CK = 156 * MiB, WS_CV = 164 * MiB, WS_XN = 172 * MiB, WS_H = 252 * MiB,
                 WS_Q = 252 * MiB, WS_K = 332 * MiB, WS_V = 352 * MiB, WS_O = 372 * MiB, WS_HB = 472 * MiB, WS_END = 552 * MiB;
constexpr size_t OUT_NK = (size_t)MT * DM, OUT_NV = OUT_NK + (size_t)32 * 4 * 256 * 256;
static_assert(WS_K - WS_Q == 80 * MiB && WS_V - WS_Q == 100 * MiB && OUT_NV - OUT_NK == 8388608, "EpiQKV offsets");
constexpr int LDS_BYTES = 147456;
constexpr int NPHASES = 1 + 10 * DEPTH;
#ifndef PH_MASK
#define PH_MASK 63
#endif
#define PH_PRO ((PH_MASK) & 1)
#define PH_MODLN ((PH_MASK) & 2)
#define PH_FFIN ((PH_MASK) & 4)
#define PH_RES ((PH_MASK) & 8)
#define PH_QKV ((PH_MASK) & 16)
#define PH_ATT ((PH_MASK) & 32)
#ifndef PROBE_SKIP_RES
#define PROBE_SKIP_RES(sp) false
#endif
#ifndef PROBE_DUP
#define PROBE_DUP 0
#endif
#ifndef MK_N_LAUNCHES
#define MK_N_LAUNCHES 1
#endif

__device__ __forceinline__ unsigned f2bf(float f) { unsigned u = __builtin_bit_cast(unsigned, f); return (u + 0x7fffu + ((u >> 16) & 1u)) >> 16; }
__device__ __forceinline__ unsigned pk2(float lo, float hi) { return f2bf(lo) | (f2bf(hi) << 16); }
__device__ __forceinline__ float wave_sum(float v) {
#pragma unroll
    for (int o = 1; o < 64; o <<= 1) v += __shfl_xor(v, o);
    return v;
}

#define XB_TMO      128
#define XB_XCNT(j)  (256  + 64 * (j))
#define XB_XSUB(j)  (1280 + 64 * (j))
#define XB_XGEN(j)  (2304 + 64 * (j))
#define XB_TOP      3328
#define XB_TOPGEN   3392
#define XCD_BAR_WORDS 3456
#define XB_SPIN_CAP (1u << 18)

__device__ __forceinline__ unsigned xb_ld(unsigned* p)              { return __hip_atomic_load(p, __ATOMIC_RELAXED, __HIP_MEMORY_SCOPE_AGENT); }
__device__ __forceinline__ unsigned xb_add(unsigned* p, unsigned v) { return __hip_atomic_fetch_add(p, v, __ATOMIC_RELAXED, __HIP_MEMORY_SCOPE_AGENT); }
__device__ __forceinline__ unsigned xb_xcc_id() { return (unsigned)__builtin_amdgcn_s_getreg((3 << 11) | 20) & 0xFu; }
#define XB_SPIN(cond, bar) do { unsigned _sp = 0; while (cond) { __builtin_amdgcn_s_sleep(1); \
    if ((++_sp & 255u) == 0u) { if (xb_ld(&(bar)[XB_TMO])) break; if (_sp > XB_SPIN_CAP) { atomicAdd(&(bar)[XB_TMO], 1u); break; } } } } while (0)

struct XcdBarrier {
    unsigned* bar; unsigned x;
    volatile LAS unsigned* st;
};

__device__ __forceinline__ XcdBarrier xcd_barrier_post(unsigned* bar, volatile LAS unsigned* st) {
    XcdBarrier b; b.bar = bar; b.x = xb_xcc_id(); b.st = st;
    if (threadIdx.x == 0) (void)xb_add(&bar[XB_XCNT(b.x)], 1u);
    return b;
}
__device__ __forceinline__ void xcd_barrier_complete(unsigned* bar, unsigned x, unsigned& nloc, unsigned& nx) {
    const unsigned G = gridDim.x * gridDim.y * gridDim.z;
    unsigned sum, cnt, mine, sp = 0u;
    for (;;) {
        sum = 0u; cnt = 0u; mine = 0u;
#pragma unroll
        for (unsigned j = 0; j < 16; ++j) { const unsigned c = xb_ld(&bar[XB_XCNT(j)]); sum += c; cnt += (c > 0u) ? 1u : 0u; mine = (j == x) ? c : mine; }
        if (sum == G) break;
        __builtin_amdgcn_s_sleep(1);
        if ((++sp & 255u) == 0u) { if (xb_ld(&bar[XB_TMO])) break; if (sp > XB_SPIN_CAP) { atomicAdd(&bar[XB_TMO], 1u); break; } }
    }
    nloc = mine > 0u ? mine : 1u; nx = cnt > 0u ? cnt : 1u;
}

__device__ __forceinline__ void xcd_barrier(const XcdBarrier& b) {
    asm volatile("s_waitcnt vmcnt(0)" ::: "memory");
    __syncthreads();
    if (threadIdx.x == 0) {
        unsigned* bar = b.bar;
        __builtin_amdgcn_s_waitcnt(0);
        unsigned nloc = b.st[0], nx = b.st[1];
        if (nloc == 0u) { xcd_barrier_complete(bar, b.x, nloc, nx); b.st[0] = nloc; b.st[1] = nx; }
        const unsigned old = xb_add(&bar[XB_XSUB(b.x)], 1u);
        const unsigned gen = old / nloc;
        if (old + 1u == (gen + 1u) * nloc) {
            __builtin_amdgcn_fence(__ATOMIC_RELEASE, "agent");
            asm volatile("s_waitcnt vmcnt(0)" ::: "memory");
            const unsigned og = xb_add(&bar[XB_TOP], 1u);
            const unsigned tg = og / nx;
            if (og + 1u == (tg + 1u) * nx) xb_add(&bar[XB_TOPGEN], 1u);
            else XB_SPIN(xb_ld(&bar[XB_TOPGEN]) == tg, bar);
            __builtin_amdgcn_fence(__ATOMIC_ACQUIRE, "agent");
            xb_add(&bar[XB_XGEN(b.x)], 1u);
            asm volatile("s_waitcnt vmcnt(0)" ::: "memory");
        } else {
            XB_SPIN(xb_ld(&bar[XB_XGEN(b.x)]) == gen, bar);
            __builtin_amdgcn_fence(__ATOMIC_ACQUIRE, "agent");
            asm volatile("s_waitcnt vmcnt(0)" ::: "memory");
        }
    }
    __syncthreads();
}

__device__ __forceinline__ void p0_transpose_item(const float* W, int K, int N, bf16* WT, int mode, LAS float* scr, int item, int lane) {
    const int nblk = N / 32, kb = item / nblk, nb = item % nblk, k0 = 64 * kb, n0 = 32 * nb;
#pragma unroll 8
    for (int i = 0; i < 32; ++i) { const int kk = 2 * i + (lane >> 5); scr[kk * 33 + (lane & 31)] = W[(size_t)(k0 + kk) * N + n0 + (lane & 31)]; }
    asm volatile("s_waitcnt lgkmcnt(0)" ::: "memory");
    const int c = lane & 7;
#pragma unroll
    for (int j = 0; j < 4; ++j) { const int n = (lane >> 3) + 8 * j; const LAS float* s = scr + (8 * c) * 33 + n;
        const int col = n0 + n; int drow = col;
        if (mode == 1) { const int up = col >= DFF ? 1 : 0; const int jj = col - up * DFF; drow = (jj >> 7) * 256 + up * 128 + (jj & 127); }
        else if (mode == 2) { drow = (col & ~255) + ((col >> 5) & 1) * 128 + ((col >> 6) & 3) * 32 + (col & 31); }
        v4u o; o.x = pk2(s[0 * 33], s[1 * 33]); o.y = pk2(s[2 * 33], s[3 * 33]); o.z = pk2(s[4 * 33], s[5 * 33]); o.w = pk2(s[6 * 33], s[7 * 33]);
        *(v4u*)(WT + (size_t)drow * K + k0 + 8 * c) = o; }
    asm volatile("s_waitcnt lgkmcnt(0)" ::: "memory");
}

__device__ __forceinline__ void p0_mods_unit(LAS unsigned char* lds, const float* c, const float* cctx, const float* wmod_l, const float* bmod_l, float* mods_l, int chunk, int tid) {
    LAS float* sc = (LAS float*)lds;
    LAS float* red = (LAS float*)(lds + 36864);
    for (int i = tid; i < 9 * 1024; i += 512) { const int cond = i >> 10, k = i & 1023; const float x = cond == 0 ? cctx[k] : c[(cond - 1) * 1024 + k]; sc[i] = x / (1.0f + __expf(-x)); }
    __syncthreads();
    const int kg = tid >> 7, tc = tid & 127; const int col = chunk * 512 + tc * 4;
    f32x4 acc[9];
#pragma unroll
    for (int q = 0; q < 9; ++q) acc[q] = (f32x4){0.f, 0.f, 0.f, 0.f};
#pragma unroll 4
    for (int k = kg * 256; k < kg * 256 + 256; ++k) { const f32x4 w = *(const f32x4*)(wmod_l + (size_t)k * NMODS + col);
#pragma unroll
        for (int q = 0; q < 9; ++q) acc[q] += w * sc[q * 1024 + k]; }
#pragma unroll
    for (int q = 0; q < 9; ++q) *(LAS f32x4*)(red + (kg * 9 + q) * 512 + tc * 4) = acc[q];
    __syncthreads();
    for (int i = tid; i < 9 * 512; i += 512) { const int q = i >> 9, j = i & 511;
        const float s = (red[(0 * 9 + q) * 512 + j] + red[(1 * 9 + q) * 512 + j]) + (red[(2 * 9 + q) * 512 + j] + red[(3 * 9 + q) * 512 + j]) + bmod_l[chunk * 512 + j];
        mods_l[q * NMODS + chunk * 512 + j] = s; }
    __syncthreads();
}

__device__ __forceinline__ void p0_rope(float* ct, float* st, int tid) {
    for (int i = tid; i < 1024; i += 512) { const int pos = i >> 4, f = i & 15;
        double fr = 1.0; for (int q = 0; q < f; ++q) fr *= 0.5623413251903491;
        const float ang = (float)pos * (float)fr;
        const double a = (double)ang; const double n = __builtin_rint(a * 0.6366197723675814); const double r = a - n * 1.5707963267948966;
        const double r2 = r * r;
        double sp = r * (1.0 + r2 * (-1.0 / 6 + r2 * (1.0 / 120 + r2 * (-1.0 / 5040 + r2 * (1.0 / 362880 + r2 * (-1.0 / 39916800 + r2 * (1.0 / 6227020800.0)))))));
        double cp = 1.0 + r2 * (-0.5 + r2 * (1.0 / 24 + r2 * (-1.0 / 720 + r2 * (1.0 / 40320 + r2 * (-1.0 / 3628800 + r2 * (1.0 / 479001600.0 + r2 * (-1.0 / 87178291200.0)))))));
        const int qd = ((int)n) & 3; double s, cc;
        if (qd == 0) { s = sp; cc = cp; } else if (qd == 1) { s = cp; cc = -sp; } else if (qd == 2) { s = -sp; cc = -cp; } else { s = -cp; cc = sp; }
        ct[i] = (float)cc; st[i] = (float)s; }
}

__device__ __forceinline__ void modln_rows4(const float* xrow, const float* ng, const float* sh, const float* sc, bf16* orow, int lane) {
    const f32x4* xr = (const f32x4*)xrow + lane;
    f32x4 v[4][4]; float s[4];
#pragma unroll
    for (int r = 0; r < 4; ++r)
#pragma unroll
        for (int j = 0; j < 4; ++j) v[r][j] = xr[r * 256 + 64 * j];
#pragma unroll
    for (int r = 0; r < 4; ++r) { float t = 0.f;
#pragma unroll
        for (int j = 0; j < 4; ++j) t += (v[r][j].x * v[r][j].x + v[r][j].y * v[r][j].y) + (v[r][j].z * v[r][j].z + v[r][j].w * v[r][j].w);
        s[r] = t; }
#pragma unroll
    for (int o = 1; o < 64; o <<= 1) {
#pragma unroll
        for (int r = 0; r < 4; ++r) s[r] += __shfl_xor(s[r], o); }
    unsigned long long* o8 = (unsigned long long*)orow + lane;
#pragma unroll
    for (int j = 0; j < 4; ++j) { const f32x4 g = ((const f32x4*)ng)[lane + 64 * j], a = ((const f32x4*)sc)[lane + 64 * j] + 1.0f, b = ((const f32x4*)sh)[lane + 64 * j];
        const f32x4 ga = g * a;
#pragma unroll
        for (int r = 0; r < 4; ++r) { const float rstd = 1.0f / sqrtf(s[r] * (1.f / DM) + 1e-6f);
            const f32x4 y = (v[r][j] * rstd) * ga + b;
            o8[r * 256 + 64 * j] = (unsigned long long)pk2(y.x, y.y) | ((unsigned long long)pk2(y.z, y.w) << 32); } }
}

__device__ __forceinline__ void modln_rows4_bf16(const bf16* hrow, const float* ng, const float* sh, const float* sc, bf16* orow, int lane) {
    const v4u* xr = (const v4u*)hrow + lane;
    v4u q[4][2]; float s[4];
#pragma unroll
    for (int r = 0; r < 4; ++r)
#pragma unroll
        for (int j = 0; j < 2; ++j) q[r][j] = xr[r * 128 + 64 * j];
#define BF_LO(w) pg8::h2_lo(w)
#define BF_HI(w) pg8::h2_hi(w)
#pragma unroll
    for (int r = 0; r < 4; ++r) { float t = 0.f;
#pragma unroll
        for (int j = 0; j < 2; ++j) { const v4u w = q[r][j];
            t += (BF_LO(w.x) * BF_LO(w.x) + BF_HI(w.x) * BF_HI(w.x)) + (BF_LO(w.y) * BF_LO(w.y) + BF_HI(w.y) * BF_HI(w.y)) + (BF_LO(w.z) * BF_LO(w.z) + BF_HI(w.z) * BF_HI(w.z)) + (BF_LO(w.w) * BF_LO(w.w) + BF_HI(w.w) * BF_HI(w.w)); }
        s[r] = t; }
#pragma unroll
    for (int o = 1; o < 64; o <<= 1) {
#pragma unroll
        for (int r = 0; r < 4; ++r) s[r] += __shfl_xor(s[r], o); }
    v4u* o16 = (v4u*)orow + lane;
#pragma unroll
    for (int j = 0; j < 2; ++j) {
        const f32x4 g0 = ((const f32x4*)ng)[2 * lane + 128 * j], g1 = ((const f32x4*)ng)[2 * lane + 128 * j + 1];
        const f32x4 a0 = ((const f32x4*)sc)[2 * lane + 128 * j] + 1.0f, a1 = ((const f32x4*)sc)[2 * lane + 128 * j + 1] + 1.0f;
        const f32x4 b0 = ((const f32x4*)sh)[2 * lane + 128 * j], b1 = ((const f32x4*)sh)[2 * lane + 128 * j + 1];
        const f32x4 ga0 = g0 * a0, ga1 = g1 * a1;
#pragma unroll
        for (int r = 0; r < 4; ++r) { const float rstd = 1.0f / sqrtf(s[r] * (1.f / DM) + 1e-6f); const v4u w = q[r][j];
            const f32x4 x0 = (f32x4){BF_LO(w.x), BF_HI(w.x), BF_LO(w.y), BF_HI(w.y)}, x1 = (f32x4){BF_LO(w.z), BF_HI(w.z), BF_LO(w.w), BF_HI(w.w)};
            const f32x4 y0 = (x0 * rstd) * ga0 + b0, y1 = (x1 * rstd) * ga1 + b1;
            v4u o; o.x = pk2(y0.x, y0.y); o.y = pk2(y0.z, y0.w); o.z = pk2(y1.x, y1.y); o.w = pk2(y1.z, y1.w);
            o16[r * 128 + 64 * j] = o; } }
#undef BF_LO
#undef BF_HI
}

__device__ __forceinline__ int crow(int r, int hi) { return (r & 3) + 8 * (r >> 2) + 4 * hi; }
__device__ __forceinline__ float xmax32(float v) {
    auto rr = __builtin_amdgcn_permlane32_swap(__float_as_uint(v), __float_as_uint(v), false, false);
    return fmaxf(__uint_as_float(rr[0]), __uint_as_float(rr[1]));
}
__device__ __forceinline__ float xsum32(float v) {
    auto rr = __builtin_amdgcn_permlane32_swap(__float_as_uint(v), __float_as_uint(v), false, false);
    return __uint_as_float(rr[0]) + __uint_as_float(rr[1]);
}
constexpr float ATT_THR = 6.0f;
__device__ __forceinline__ void attn_decode(int u, int l, bool full, const bf16* Qb, bf16* Ob, const bf16* Kb, const bf16* Vb, const bf16* CK, const bf16* CV, const float* sinkp,
                                            const bf16*& Qu, bf16*& Ou, const bf16*& K0, const bf16*& V0, int& n0, const bf16*& K1, const bf16*& V1, int& n1, int& qrel0, bool& win, float& sink2) {
    int h;
    if (u < 2048) { const int b = u >> 8; const int c8 = u & 255; const int xcd = c8 & 7, slot = (xcd & 1) * 32 + (c8 >> 3);
        const int kvh = xcd >> 1; h = kvh * 4 + (slot >> 4); const int qb = slot & 15; const size_t rowb = (size_t)MP + (size_t)b * LSEQ; const int q0 = qb * 256;
        Qu = Qb + (rowb + q0) * 1024 + h * 64; Ou = Ob + (rowb + q0) * 1024 + h * 64;
        K0 = CK + (size_t)((b * 4 + l) * PAST) * 256 + kvh * 64; V0 = CV + (size_t)((b * 4 + l) * PAST) * 256 + kvh * 64; n0 = PAST / 128;
        int klo = 0, khi = LSEQ; if (!full) { klo = q0 - 128 < 0 ? 0 : q0 - 128; khi = q0 + 384 > LSEQ ? LSEQ : q0 + 384; }
        n1 = (khi - klo) / 128; K1 = Kb + (rowb + klo) * 256 + kvh * 64; V1 = Vb + (rowb + klo) * 256 + kvh * 64; qrel0 = q0 - klo; win = !full;
    } else { const int v = u - 2048; const int b = v >> 4; h = v & 15; const int kvh = h >> 2; const size_t rowb = (size_t)b * CSEQ;
        Qu = Qb + rowb * 1024 + h * 64; Ou = Ob + rowb * 1024 + h * 64; n0 = 0; n1 = CSEQ / 128;
        K1 = Kb + rowb * 256 + kvh * 64; V1 = Vb + rowb * 256 + kvh * 64; K0 = K1; V0 = V1; qrel0 = 0; win = false; }
    sink2 = 0.f; if (!full) sink2 = sinkp[(l >> 1) * 16 + h] * 1.4426950408889634f;
}
__device__ __forceinline__ void attn_phase(LAS unsigned char* lds, const bf16* Qb, bf16* Ob, const bf16* Kb, const bf16* Vb, const bf16* CK, const bf16* CV, const float* sinkp, const float* qg, const float* kg, const unsigned* ckmax,
                                           const int l, const bool full, const int bx, const int G, const int tid) {
    const bool has_sink = !full;
    bool track;
    { float gq = fabsf(qg[tid & 63]), gk = fabsf(kg[tid & 63]);
#pragma unroll
      for (int o = 1; o < 64; o <<= 1) { gq = fmaxf(gq, __shfl_xor(gq, o)); gk = fmaxf(gk, __shfl_xor(gk, o)); }
      const float kn = fmaxf(8.0f * gk, sqrtf(__uint_as_float(ckmax[l])));
      const float bound = 8.0f * gq * kn * (0.125f * 1.4426950408889634f); track = !(bound < 64.0f); track = __builtin_amdgcn_readfirstlane((int)track) != 0; }
    const bf16 *Qu, *K0, *V0, *K1, *V1; bf16* Ou; int n0, n1, qrel0; bool win; float sink2;
    attn_decode(bx, l, full, Qb, Ob, Kb, Vb, CK, CV, sinkp, Qu, Ou, K0, V0, n0, K1, V1, n1, qrel0, win, sink2);
    const int lane = tid & 63, r32 = lane & 31, hi = lane >> 5; const int wid = __builtin_amdgcn_readfirstlane(tid >> 6);
    const int lrow = tid >> 3, lch = tid & 7;
    const unsigned kw = lrow * 128 + ((lch ^ ((lrow >> 1) & 7)) * 16);
    const unsigned vw = 16384 + (lch >> 2) * 4096 + (lrow >> 4) * 1024 + (lrow & 15) * 64 + (lch & 3) * 16;
    const size_t goff = (size_t)lrow * 256 + lch * 8;
    const bf16* Qw = Qu + (size_t)(wid * 32 + r32) * 1024;
    bf16x8 qr[4];
#pragma unroll
    for (int d0 = 0; d0 < 4; ++d0) qr[d0] = *(const bf16x8*)(Qw + d0 * 16 + hi * 8);
    v4u kreg[2], vreg[2];
    { const bf16* kp = n0 > 0 ? K0 : K1; const bf16* vp = n0 > 0 ? V0 : V1;
#pragma unroll
      for (int i = 0; i < 2; ++i) { kreg[i] = *(const v4u*)(kp + goff + i * (64 * 256)); vreg[i] = *(const v4u*)(vp + goff + i * (64 * 256)); } }
#pragma unroll
    for (int i = 0; i < 2; ++i) { *(LAS v4u*)(lds + kw + i * 8192) = kreg[i]; *(LAS v4u*)(lds + vw + i * 8192) = vreg[i]; }
    asm volatile("" : "+v"(qr[0]), "+v"(qr[1]), "+v"(qr[2]), "+v"(qr[3]));
    __syncthreads();
    unsigned par = 0u;
    bf16x8 qn[4];
#pragma unroll
    for (int d0 = 0; d0 < 4; ++d0) qn[d0] = qr[d0];
    const unsigned kr = r32 * 128; const int sw = (r32 >> 1) & 7;
    const unsigned vr = 16384 + ((lane >> 4) & 1) * 32 + (lane & 3) * 8 + (4 * hi + ((lane & 15) >> 2)) * 64;
    for (int u = bx; u < 2048 + 512; u += G) {
        const bool has_next = u + G < 2048 + 512;
        const bf16 *nQu = Qu, *nK0 = K0, *nV0 = V0, *nK1 = K1, *nV1 = V1; bf16* nOu = Ou; int nn0 = n0, nn1 = n1, nqrel0 = qrel0; bool nwin = win; float nsink2 = sink2;
        if (has_next) attn_decode(u + G, l, full, Qb, Ob, Kb, Vb, CK, CV, sinkp, nQu, nOu, nK0, nV0, nn0, nK1, nV1, nn1, nqrel0, nwin, nsink2);
        asm volatile("" : "+v"(qn[0]), "+v"(qn[1]), "+v"(qn[2]), "+v"(qn[3]));
#pragma unroll
        for (int d0 = 0; d0 < 4; ++d0) qr[d0] = qn[d0];
        const int NT = n0 + n1;
    float m = 0.f, l = 0.f;
    f32x16 o0, o1;
#pragma unroll
    for (int r = 0; r < 16; ++r) { o0[r] = 0.f; o1[r] = 0.f; }
    for (int t = 0; t < NT; ++t) {
        const unsigned bo = par * 32768u;
        const bool lastt = t + 1 >= NT; const bool more = !lastt || has_next;
        if (more) { const int tn = t + 1; const bf16* kp = tn < n0 ? K0 + (size_t)tn * (128 * 256) : K1 + (size_t)(tn - n0) * (128 * 256); const bf16* vp = tn < n0 ? V0 + (size_t)tn * (128 * 256) : V1 + (size_t)(tn - n0) * (128 * 256);
            if (lastt) { kp = nn0 > 0 ? nK0 : nK1; vp = nn0 > 0 ? nV0 : nV1; }
#pragma unroll
            for (int i = 0; i < 2; ++i) { kreg[i] = *(const v4u*)(kp + goff + i * (64 * 256)); vreg[i] = *(const v4u*)(vp + goff + i * (64 * 256)); } }
        f32x16 p[4];
        {
            bf16x8 kfa[4], kfb[4];
#define LOADK(dst, c) do { _Pragma("unroll") for (int d0 = 0; d0 < 4; ++d0) dst[d0] = *(const LAS bf16x8*)(lds + bo + kr + (c) * 4096 + (unsigned)(((2 * d0 + hi) ^ sw) * 16)); } while (0)
#define MMAK(c, src) do { p[c] = __builtin_amdgcn_mfma_f32_32x32x16_bf16(src[0], qr[0], pinit, 0, 0, 0); _Pragma("unroll") for (int d0 = 1; d0 < 4; ++d0) p[c] = __builtin_amdgcn_mfma_f32_32x32x16_bf16(src[d0], qr[d0], p[c], 0, 0, 0); } while (0)
#define SB() __builtin_amdgcn_sched_barrier(0)
#define QK_ALL() do { LOADK(kfa, 0); SB(); LOADK(kfb, 1); SB(); MMAK(0, kfa); SB(); LOADK(kfa, 2); SB(); MMAK(1, kfb); SB(); LOADK(kfb, 3); SB(); MMAK(2, kfa); SB(); MMAK(3, kfb); SB(); } while (0)
            if (track) { f32x16 pinit; const float negm = -m;
#pragma unroll
                for (int r = 0; r < 16; ++r) pinit[r] = negm;
                QK_ALL(); }
            else { const f32x16 pinit = {0.f, 0.f, 0.f, 0.f, 0.f, 0.f, 0.f, 0.f, 0.f, 0.f, 0.f, 0.f, 0.f, 0.f, 0.f, 0.f};
                QK_ALL(); }
#undef QK_ALL
#undef LOADK
#undef MMAK
        }
        if (lastt && has_next) { const bf16* nQw = nQu + (size_t)(wid * 32 + r32) * 1024;
#pragma unroll
            for (int d0 = 0; d0 < 4; ++d0) qn[d0] = *(const bf16x8*)(nQw + d0 * 16 + hi * 8); }
        if (win && t >= n0) { const int kb = (t - n0) * 128; const int qw = qrel0 + wid * 32;
            if (!((kb + 127 - qw <= 128) && (qw + 31 - kb <= 128))) { const int q = qw + r32;
#pragma unroll
                for (int c = 0; c < 4; ++c)
#pragma unroll
                    for (int r = 0; r < 16; ++r) { const int d = q - (kb + 32 * c + crow(r, hi)); if (d > 128 || d < -128) p[c][r] = -INFINITY; } } }
        if (track) {
        float mx0 = fmaxf(p[0][0], p[1][0]), mx1 = fmaxf(p[2][0], p[3][0]);
#pragma unroll
        for (int r = 1; r < 16; ++r) { mx0 = fmaxf(fmaxf(mx0, p[0][r]), p[1][r]); mx1 = fmaxf(fmaxf(mx1, p[2][r]), p[3][r]); }
        const float mx = xmax32(fmaxf(mx0, mx1));
        if (__builtin_expect(__any(mx > ATT_THR), 0)) {
            const float dl = fmaxf(mx, 0.f); m += dl; const float alpha = __builtin_amdgcn_exp2f(-dl); l *= alpha;
#pragma unroll
            for (int c = 0; c < 4; ++c)
#pragma unroll
                for (int r = 0; r < 16; ++r) p[c][r] -= dl;
#pragma unroll
            for (int r = 0; r < 16; ++r) { o0[r] *= alpha; o1[r] *= alpha; }
        }
        }
        typedef float f32x2_t __attribute__((ext_vector_type(2)));
        f32x2_t ls0 = {0.f, 0.f}, ls1 = {0.f, 0.f}, ls2 = {0.f, 0.f}, ls3 = {0.f, 0.f};
#pragma unroll
        for (int r = 0; r < 16; r += 2) {
            p[0][r] = __builtin_amdgcn_exp2f(p[0][r]); p[0][r + 1] = __builtin_amdgcn_exp2f(p[0][r + 1]); p[1][r] = __builtin_amdgcn_exp2f(p[1][r]); p[1][r + 1] = __builtin_amdgcn_exp2f(p[1][r + 1]);
            p[2][r] = __builtin_amdgcn_exp2f(p[2][r]); p[2][r + 1] = __builtin_amdgcn_exp2f(p[2][r + 1]); p[3][r] = __builtin_amdgcn_exp2f(p[3][r]); p[3][r + 1] = __builtin_amdgcn_exp2f(p[3][r + 1]);
            ls0 += (f32x2_t){p[0][r], p[0][r + 1]}; ls1 += (f32x2_t){p[1][r], p[1][r + 1]}; ls2 += (f32x2_t){p[2][r], p[2][r + 1]}; ls3 += (f32x2_t){p[3][r], p[3][r + 1]}; }
        { const f32x2_t t = (ls0 + ls1) + (ls2 + ls3); l += t.x + t.y; }
        {
            s16x4 va[4], vb[4];
#define LOADV(dst, ks) do { _Pragma("unroll") for (int d0 = 0; d0 < 2; ++d0) { const unsigned va_ = bo + vr + ((ks) >> 2) * 8192 + d0 * 4096 + ((ks) & 3) * 1024; \
                dst[2 * d0] = __builtin_bit_cast(s16x4, __builtin_amdgcn_ds_read_tr16_b64_v4i16((LAS s16x4*)(lds + va_))); \
                dst[2 * d0 + 1] = __builtin_bit_cast(s16x4, __builtin_amdgcn_ds_read_tr16_b64_v4i16((LAS s16x4*)(lds + va_ + 512))); } } while (0)
#define MMAV(ks, src) do { const int c_ = (ks) >> 1, rb_ = ((ks) & 1) * 8; \
                const v4u pwv = (v4u){pg8::cvt_pk_bf16(p[c_][rb_], p[c_][rb_ + 1]), pg8::cvt_pk_bf16(p[c_][rb_ + 2], p[c_][rb_ + 3]), pg8::cvt_pk_bf16(p[c_][rb_ + 4], p[c_][rb_ + 5]), pg8::cvt_pk_bf16(p[c_][rb_ + 6], p[c_][rb_ + 7])}; \
                const bf16x8 pa = __builtin_bit_cast(bf16x8, pwv); \
                const bf16x8 vf0 = (bf16x8){src[0][0], src[0][1], src[0][2], src[0][3], src[1][0], src[1][1], src[1][2], src[1][3]}; \
                const bf16x8 vf1 = (bf16x8){src[2][0], src[2][1], src[2][2], src[2][3], src[3][0], src[3][1], src[3][2], src[3][3]}; \
                o0 = __builtin_amdgcn_mfma_f32_32x32x16_bf16(vf0, pa, o0, 0, 0, 0); o1 = __builtin_amdgcn_mfma_f32_32x32x16_bf16(vf1, pa, o1, 0, 0, 0); } while (0)
            LOADV(va, 0); SB();
            LOADV(vb, 1); SB(); MMAV(0, va); SB();
            LOADV(va, 2); SB(); MMAV(1, vb); SB();
            LOADV(vb, 3); SB(); MMAV(2, va); SB();
            LOADV(va, 4); SB(); MMAV(3, vb); SB();
            LOADV(vb, 5); SB(); MMAV(4, va); SB();
            LOADV(va, 6); SB(); MMAV(5, vb); SB();
            LOADV(vb, 7); SB(); MMAV(6, va); SB();
            MMAV(7, vb); SB();
#undef LOADV
#undef MMAV
#undef SB
        }
        if (more) {
#pragma unroll
            for (int i = 0; i < 2; ++i) { *(LAS v4u*)(lds + (bo ^ 32768u) + kw + i * 8192) = kreg[i]; *(LAS v4u*)(lds + (bo ^ 32768u) + vw + i * 8192) = vreg[i]; } }
        __syncthreads(); par ^= 1u;
    }
    l = xsum32(l);
    if (has_sink) l += __builtin_amdgcn_exp2f(sink2 - m);
    const float inv = 1.0f / l;
    bf16* Ow = Ou + (size_t)(wid * 32 + r32) * 1024 + 4 * hi;
#pragma unroll
    for (int g = 0; g < 4; ++g) {
        v2u w0, w1; w0.x = pg8::cvt_pk_bf16(o0[4 * g] * inv, o0[4 * g + 1] * inv); w0.y = pg8::cvt_pk_bf16(o0[4 * g + 2] * inv, o0[4 * g + 3] * inv);
        w1.x = pg8::cvt_pk_bf16(o1[4 * g] * inv, o1[4 * g + 1] * inv); w1.y = pg8::cvt_pk_bf16(o1[4 * g + 2] * inv, o1[4 * g + 3] * inv);
        *(v2u*)(Ow + 8 * g) = w0; *(v2u*)(Ow + 32 + 8 * g) = w1; }
        Qu = nQu; Ou = nOu; K0 = nK0; V0 = nV0; K1 = nK1; V1 = nV1; n0 = nn0; n1 = nn1; qrel0 = nqrel0; win = nwin; sink2 = nsink2;
    }
}

__device__ __forceinline__ void attn2_decode(int u, int l, bool full, const bf16* Kb, const bf16* Vb, const bf16* CK, const bf16* CV,
                                             size_t& rowbase, int& h0, bool& pair, const bf16*& K0, const bf16*& V0, int& n0, const bf16*& K1, const bf16*& V1, int& n1, int& qrel0, bool& win) {
    if (u < 1024) { const int b = u >> 7, idx = u & 127, xcd = idx & 7, j = (xcd & 1) * 16 + (idx >> 3), kvh = xcd >> 1; h0 = kvh * 4 + (j >> 3); const int q0 = (j & 7) * 512;
        const size_t rowb = (size_t)MP + (size_t)b * LSEQ; rowbase = rowb + q0; pair = false;
        K0 = CK + (size_t)((b * 4 + l) * PAST) * 256 + kvh * 64; V0 = CV + (size_t)((b * 4 + l) * PAST) * 256 + kvh * 64; n0 = PAST / 128;
        int klo = 0, khi = LSEQ; if (!full) { klo = q0 - 128 < 0 ? 0 : q0 - 128; khi = q0 + 640 > LSEQ ? LSEQ : q0 + 640; }
        n1 = (khi - klo) / 128; K1 = Kb + (rowb + klo) * 256 + kvh * 64; V1 = Vb + (rowb + klo) * 256 + kvh * 64; qrel0 = q0 - klo; win = !full;
    } else { const int v = u - 1024, b = v >> 3, hp = v & 7, kvh = hp >> 1; h0 = 2 * hp; pair = true; rowbase = (size_t)b * CSEQ;
        n0 = 0; n1 = CSEQ / 128; K1 = Kb + rowbase * 256 + kvh * 64; V1 = Vb + rowbase * 256 + kvh * 64; K0 = K1; V0 = V1; qrel0 = 0; win = false; }
}
__device__ __forceinline__ void attn_phase2(LAS unsigned char* lds, const bf16* Qb, bf16* Ob, const bf16* Kb, const bf16* Vb, const bf16* CK, const bf16* CV, const float* sinkp, const float* qg, const float* kg, const unsigned* ckmax,
                                            const int l, const bool full, const int bx, const int G, const int tid) {
    const bool has_sink = !full;
    bool track;
    { float gq = fabsf(qg[tid & 63]), gk = fabsf(kg[tid & 63]);
#pragma unroll
      for (int o = 1; o < 64; o <<= 1) { gq = fmaxf(gq, __shfl_xor(gq, o)); gk = fmaxf(gk, __shfl_xor(gk, o)); }
      const float kn = fmaxf(8.0f * gk, sqrtf(__uint_as_float(ckmax[l])));
      const float bound = 8.0f * gq * kn * (0.125f * 1.4426950408889634f); track = !(bound < 64.0f); track = __builtin_amdgcn_readfirstlane((int)track) != 0; }
    const int lane = tid & 63, r32 = lane & 31, hi = lane >> 5; const int wid = __builtin_amdgcn_readfirstlane(tid >> 6);
    const int lrow = tid >> 3, lch = tid & 7;
    const unsigned kw = lrow * 128 + ((lch ^ ((lrow >> 1) & 7)) * 16);
    const unsigned vw = 16384 + (lch >> 2) * 4096 + (lrow >> 4) * 1024 + (lrow & 15) * 64 + (lch & 3) * 16;
    const size_t goff = (size_t)lrow * 256 + lch * 8;
    const unsigned kr = r32 * 128; const int sw = (r32 >> 1) & 7;
    const unsigned vr = 16384 + ((lane >> 4) & 1) * 32 + (lane & 3) * 8 + (4 * hi + ((lane & 15) >> 2)) * 64;
    size_t rowbase; int h0, n0, n1, qrel0; bool pair, win; const bf16 *K0, *V0, *K1, *V1;
    attn2_decode(bx, l, full, Kb, Vb, CK, CV, rowbase, h0, pair, K0, V0, n0, K1, V1, n1, qrel0, win);
    bf16x8 qr[2][4];
    { const int h = pair ? h0 + (wid >> 2) : h0; const int wrow = pair ? (wid & 3) * 64 : wid * 64;
#pragma unroll
      for (int qb = 0; qb < 2; ++qb) { const bf16* Qw = Qb + (rowbase + wrow + qb * 32 + r32) * 1024 + h * 64;
#pragma unroll
        for (int d0 = 0; d0 < 4; ++d0) qr[qb][d0] = *(const bf16x8*)(Qw + d0 * 16 + hi * 8); } }
    v4u kreg[2], vreg[2];
    { const bf16* kp = n0 > 0 ? K0 : K1; const bf16* vp = n0 > 0 ? V0 : V1;
#pragma unroll
      for (int i = 0; i < 2; ++i) { kreg[i] = *(const v4u*)(kp + goff + i * (64 * 256)); vreg[i] = *(const v4u*)(vp + goff + i * (64 * 256)); } }
#pragma unroll
    for (int i = 0; i < 2; ++i) { *(LAS v4u*)(lds + kw + i * 8192) = kreg[i]; *(LAS v4u*)(lds + vw + i * 8192) = vreg[i]; }
    __syncthreads();
    unsigned par = 0u;
#define A2SB() __builtin_amdgcn_sched_barrier(0)
    for (int u = bx; u < 1024 + 256; u += G) {
        const bool has_next = u + G < 1024 + 256;
        size_t nrowbase = rowbase; int nh0 = h0, nn0 = n0, nn1 = n1, nqrel0 = qrel0; bool npair = pair, nwin = win; const bf16 *nK0 = K0, *nV0 = V0, *nK1 = K1, *nV1 = V1;
        if (has_next) attn2_decode(u + G, l, full, Kb, Vb, CK, CV, nrowbase, nh0, npair, nK0, nV0, nn0, nK1, nV1, nn1, nqrel0, nwin);
        asm volatile("" : "+v"(qr[0][0]), "+v"(qr[0][1]), "+v"(qr[0][2]), "+v"(qr[0][3]), "+v"(qr[1][0]), "+v"(qr[1][1]), "+v"(qr[1][2]), "+v"(qr[1][3]));
        const int NT = n0 + n1;
        const int h = pair ? h0 + (wid >> 2) : h0; const int wrow = pair ? (wid & 3) * 64 : wid * 64;
        float m[2] = {0.f, 0.f}, lsum[2] = {0.f, 0.f};
        f32x16 o[2][2];
#pragma unroll
        for (int qb = 0; qb < 2; ++qb)
#pragma unroll
            for (int r = 0; r < 16; ++r) { o[qb][0][r] = 0.f; o[qb][1][r] = 0.f; }
        auto iter = [&](const int t, auto lt) __attribute__((always_inline)) { constexpr bool LASTT = decltype(lt)::value;
            const unsigned bo0 = par * 32768u;
            const bool lastt = LASTT; const bool more = !lastt || has_next;
            if (more) { const int tn = t + 1; const bf16* kp = tn < n0 ? K0 + (size_t)tn * (128 * 256) : K1 + (size_t)(tn - n0) * (128 * 256); const bf16* vp = tn < n0 ? V0 + (size_t)tn * (128 * 256) : V1 + (size_t)(tn - n0) * (128 * 256);
                if (lastt) { kp = nn0 > 0 ? nK0 : nK1; vp = nn0 > 0 ? nV0 : nV1; }
#pragma unroll
                for (int i = 0; i < 2; ++i) { kreg[i] = *(const v4u*)(kp + goff + i * (64 * 256)); vreg[i] = *(const v4u*)(vp + goff + i * (64 * 256)); } }
            const int qw = qrel0 + wrow;
#pragma unroll
            for (int hf = 0; hf < 2; ++hf) {
            const unsigned bo = bo0 + hf * 8192u;
            bool live = true; int kb = 0;
            if (win && t >= n0) { kb = (t - n0) * 128 + hf * 64; live = (kb - (qw + 63) <= 128) && (qw - (kb + 63) <= 128); }
            if (live) {
                f32x16 p[2][2];
                {   bf16x8 kfa[4];
#define A2LOADK(dst, c) do { _Pragma("unroll") for (int d0 = 0; d0 < 4; ++d0) dst[d0] = *(const LAS bf16x8*)(lds + bo + kr + (c) * 4096 + (unsigned)(((2 * d0 + hi) ^ sw) * 16)); } while (0)
#define A2MFMA(c, d0) do { _Pragma("unroll") for (int qb = 0; qb < 2; ++qb) \
                        p[qb][c] = (zeroc && (d0) == 0) ? __builtin_amdgcn_mfma_f32_32x32x16_bf16(kfa[d0], qr[qb][d0], zvec, 0, 0, 0) : __builtin_amdgcn_mfma_f32_32x32x16_bf16(kfa[d0], qr[qb][d0], p[qb][c], 0, 0, 0); } while (0)
#define A2LOADK1(c, d0) kfa[d0] = *(const LAS bf16x8*)(lds + bo + kr + (c) * 4096 + (unsigned)(((2 * (d0) + hi) ^ sw) * 16))
#define A2QK() do { A2LOADK(kfa, 0); A2SB(); \
                        A2MFMA(0, 0); A2LOADK1(1, 0); A2SB(); A2MFMA(0, 1); A2LOADK1(1, 1); A2SB(); A2MFMA(0, 2); A2LOADK1(1, 2); A2SB(); A2MFMA(0, 3); A2LOADK1(1, 3); A2SB(); \
                        A2MFMA(1, 0); A2SB(); A2MFMA(1, 1); A2SB(); A2MFMA(1, 2); A2SB(); A2MFMA(1, 3); A2SB(); } while (0)
                    const f32x16 zvec = {0.f, 0.f, 0.f, 0.f, 0.f, 0.f, 0.f, 0.f, 0.f, 0.f, 0.f, 0.f, 0.f, 0.f, 0.f, 0.f};
                    if (track) { constexpr bool zeroc = false;
#pragma unroll
                        for (int qb = 0; qb < 2; ++qb)
#pragma unroll
                            for (int c = 0; c < 2; ++c)
#pragma unroll
                                for (int r = 0; r < 16; ++r) p[qb][c][r] = -m[qb];
                        A2QK(); }
                    else { constexpr bool zeroc = true; A2QK(); }
#undef A2QK
#undef A2MFMA
#undef A2LOADK1
#undef A2LOADK
                }
                if (LASTT && hf == 1 && has_next) { const int nh = npair ? nh0 + (wid >> 2) : nh0; const int nwrow = npair ? (wid & 3) * 64 : wid * 64;
#pragma unroll
                    for (int qb = 0; qb < 2; ++qb) { const bf16* Qw = Qb + (nrowbase + nwrow + qb * 32 + r32) * 1024 + nh * 64;
#pragma unroll
                        for (int d0 = 0; d0 < 4; ++d0) qr[qb][d0] = *(const bf16x8*)(Qw + d0 * 16 + hi * 8); } }
#pragma unroll
                for (int qb = 0; qb < 2; ++qb) {
                    if (win && t >= n0) { const int qwb = qw + qb * 32;
                        if (!((kb + 63 - qwb <= 128) && (qwb + 31 - kb <= 128))) { const int q = qwb + r32;
#pragma unroll
                            for (int c = 0; c < 2; ++c)
#pragma unroll
                                for (int r = 0; r < 16; ++r) { const int d = q - (kb + 32 * c + crow(r, hi)); if (d > 128 || d < -128) p[qb][c][r] = -INFINITY; } } }
                    if (track) {
                        float mx0 = fmaxf(p[qb][0][0], p[qb][1][0]);
#pragma unroll
                        for (int r = 1; r < 16; ++r) mx0 = fmaxf(fmaxf(mx0, p[qb][0][r]), p[qb][1][r]);
                        const float mx = xmax32(mx0);
                        if (__builtin_expect(__any(mx > ATT_THR), 0)) { const float dl = fmaxf(mx, 0.f); m[qb] += dl; const float alpha = __builtin_amdgcn_exp2f(-dl); lsum[qb] *= alpha;
#pragma unroll
                            for (int c = 0; c < 2; ++c)
#pragma unroll
                                for (int r = 0; r < 16; ++r) p[qb][c][r] -= dl;
#pragma unroll
                            for (int r = 0; r < 16; ++r) { o[qb][0][r] *= alpha; o[qb][1][r] *= alpha; } }
                    }
                    typedef float f32x2_t __attribute__((ext_vector_type(2)));
                    f32x2_t s0 = {0.f, 0.f}, s1 = {0.f, 0.f};
#pragma unroll
                    for (int r = 0; r < 16; r += 2) {
                        p[qb][0][r] = __builtin_amdgcn_exp2f(p[qb][0][r]); p[qb][0][r + 1] = __builtin_amdgcn_exp2f(p[qb][0][r + 1]); p[qb][1][r] = __builtin_amdgcn_exp2f(p[qb][1][r]); p[qb][1][r + 1] = __builtin_amdgcn_exp2f(p[qb][1][r + 1]);
                        s0 += (f32x2_t){p[qb][0][r], p[qb][0][r + 1]}; s1 += (f32x2_t){p[qb][1][r], p[qb][1][r + 1]}; }
                    { const f32x2_t tt = s0 + s1; lsum[qb] += tt.x + tt.y; }
                }
                {   s16x4 va[4], vb[4];
#define A2LOADV(dst, ks) do { _Pragma("unroll") for (int d0 = 0; d0 < 2; ++d0) { const unsigned va_ = bo + vr + d0 * 4096 + (ks) * 1024; \
                        dst[2 * d0] = __builtin_bit_cast(s16x4, __builtin_amdgcn_ds_read_tr16_b64_v4i16((LAS s16x4*)(lds + va_))); \
                        dst[2 * d0 + 1] = __builtin_bit_cast(s16x4, __builtin_amdgcn_ds_read_tr16_b64_v4i16((LAS s16x4*)(lds + va_ + 512))); } } while (0)
#define A2MMAV(ks, src) do { const int c_ = (ks) >> 1, rb_ = ((ks) & 1) * 8; \
                        const bf16x8 vf0 = (bf16x8){src[0][0], src[0][1], src[0][2], src[0][3], src[1][0], src[1][1], src[1][2], src[1][3]}; \
                        const bf16x8 vf1 = (bf16x8){src[2][0], src[2][1], src[2][2], src[2][3], src[3][0], src[3][1], src[3][2], src[3][3]}; \
                        _Pragma("unroll") for (int qb = 0; qb < 2; ++qb) { \
                            const v4u pwv = (v4u){pg8::cvt_pk_bf16(p[qb][c_][rb_], p[qb][c_][rb_ + 1]), pg8::cvt_pk_bf16(p[qb][c_][rb_ + 2], p[qb][c_][rb_ + 3]), pg8::cvt_pk_bf16(p[qb][c_][rb_ + 4], p[qb][c_][rb_ + 5]), pg8::cvt_pk_bf16(p[qb][c_][rb_ + 6], p[qb][c_][rb_ + 7])}; \
                            const bf16x8 pa = __builtin_bit_cast(bf16x8, pwv); \
                            o[qb][0] = __builtin_amdgcn_mfma_f32_32x32x16_bf16(vf0, pa, o[qb][0], 0, 0, 0); o[qb][1] = __builtin_amdgcn_mfma_f32_32x32x16_bf16(vf1, pa, o[qb][1], 0, 0, 0); } } while (0)
                    A2LOADV(va, 0); A2SB();
                    A2LOADV(vb, 1); A2SB(); A2MMAV(0, va); A2SB();
                    A2LOADV(va, 2); A2SB(); A2MMAV(1, vb); A2SB();
                    A2LOADV(vb, 3); A2SB(); A2MMAV(2, va); A2SB();
                    A2MMAV(3, vb); A2SB();
#undef A2LOADV
#undef A2MMAV
                }
            }
            else if (LASTT && hf == 1 && has_next) {     const int nh = npair ? nh0 + (wid >> 2) : nh0; const int nwrow = npair ? (wid & 3) * 64 : wid * 64;
#pragma unroll
                    for (int qb = 0; qb < 2; ++qb) { const bf16* Qw = Qb + (nrowbase + nwrow + qb * 32 + r32) * 1024 + nh * 64;
#pragma unroll
                        for (int d0 = 0; d0 < 4; ++d0) qr[qb][d0] = *(const bf16x8*)(Qw + d0 * 16 + hi * 8); } }
            }
            if (more) {
#pragma unroll
                for (int i = 0; i < 2; ++i) { *(LAS v4u*)(lds + (bo0 ^ 32768u) + kw + i * 8192) = kreg[i]; *(LAS v4u*)(lds + (bo0 ^ 32768u) + vw + i * 8192) = vreg[i]; } }
            __syncthreads(); par ^= 1u;
        };
        for (int t = 0; t + 1 < NT; ++t) iter(t, std::false_type{});
        iter(NT - 1, std::true_type{});
        float sink2 = 0.f; if (has_sink) sink2 = sinkp[(l >> 1) * 16 + h] * 1.4426950408889634f;
#pragma unroll
        for (int qb = 0; qb < 2; ++qb) {
            float lt = xsum32(lsum[qb]);
            if (has_sink) lt += __builtin_amdgcn_exp2f(sink2 - m[qb]);
            const float inv = 1.0f / lt;
            bf16* Ow = Ob + (rowbase + wrow + qb * 32 + r32) * 1024 + h * 64 + 4 * hi;
#pragma unroll
            for (int g = 0; g < 4; ++g) {
                v2u w0, w1; w0.x = pg8::cvt_pk_bf16(o[qb][0][4 * g] * inv, o[qb][0][4 * g + 1] * inv); w0.y = pg8::cvt_pk_bf16(o[qb][0][4 * g + 2] * inv, o[qb][0][4 * g + 3] * inv);
                w1.x = pg8::cvt_pk_bf16(o[qb][1][4 * g] * inv, o[qb][1][4 * g + 1] * inv); w1.y = pg8::cvt_pk_bf16(o[qb][1][4 * g + 2] * inv, o[qb][1][4 * g + 3] * inv);
                *(v2u*)(Ow + 8 * g) = w0; *(v2u*)(Ow + 32 + 8 * g) = w1; } }
        rowbase = nrowbase; h0 = nh0; pair = npair; K0 = nK0; V0 = nV0; K1 = nK1; V1 = nV1; n0 = nn0; n1 = nn1; qrel0 = nqrel0; win = nwin;
    }
#undef A2SB
}

struct Args { void* p[18]; int ph_lo, ph_hi; };
#define INP(k) ((const float*)a.p[(k) + zz])
__device__ __forceinline__ void prologue_phase(const Args& a, LAS unsigned char* lds, const int G, const int bx) {
    const int zz = 0; const int tid = threadIdx.x, lane = tid & 63; const int wave = __builtin_amdgcn_readfirstlane(tid >> 6); const int gw = bx * 8 + wave, NGW = G * 8;
    unsigned char* ws = (unsigned char*)a.p[17];
    float* mods = (float*)(ws + WS_MODS); float* ropec = (float*)(ws + WS_ROPE); float* ropes = ropec + 1024;
    bf16* CK = (bf16*)(ws + WS_CK); bf16* CV = (bf16*)(ws + WS_CV);
            for (int u = bx; u < DEPTH * 18; u += G) { const int l = u / 18, chunk = u % 18;
                p0_mods_unit(lds, INP(4), INP(5), INP(6) + (size_t)l * DM * NMODS, INP(7) + (size_t)l * NMODS, mods + (size_t)l * 9 * NMODS, chunk, tid); }
            if (bx == G - 1) p0_rope(ropec, ropes, tid);
            LAS float* scr = (LAS float*)(lds + wave * 16384);
            constexpr int I_QKV = 16 * 48, I_O = 16 * 32, I_1 = 16 * 176, I_2 = 44 * 32, I_L = I_QKV + I_O + 2 * I_1 + 2 * I_2;
            for (int it = gw; it < DEPTH * I_L; it += NGW) {
                const int l = it / I_L; int r = it % I_L;
                if (r < I_QKV) { p0_transpose_item(INP(9) + (size_t)l * DM * NQKV, DM, NQKV, (bf16*)(ws + WS_WQKV) + (size_t)l * NQKV * DM, 2, scr, r, lane); continue; } r -= I_QKV;
                if (r < I_O) { p0_transpose_item(INP(10) + (size_t)l * DM * DM, DM, DM, (bf16*)(ws + WS_WO) + (size_t)l * DM * DM, 0, scr, r, lane); continue; } r -= I_O;
                if (r < 2 * I_1) { const int w = r / I_1; r -= w * I_1;
                    p0_transpose_item(INP(14) + (size_t)(l * 2 + w) * DM * 2 * DFF, DM, 2 * DFF, (bf16*)(ws + WS_W1) + (size_t)(l * 2 + w) * 2 * DFF * DM, 1, scr, r, lane); continue; } r -= 2 * I_1;
                { const int w = r / I_2; r -= w * I_2;
                    p0_transpose_item(INP(15) + (size_t)(l * 2 + w) * DFF * DM, DFF, DM, (bf16*)(ws + WS_W2) + (size_t)(l * 2 + w) * DM * DFF, 0, scr, r, lane); }
            }
            { const size_t n8 = (size_t)8 * 4 * 512 * 256 / 8;
                for (size_t i = (size_t)bx * 512 + tid; i < 2 * n8; i += (size_t)G * 512) { const bool isv = i >= n8; const size_t j = isv ? i - n8 : i;
                    const float* src = (isv ? INP(3) : INP(2)) + j * 8; bf16* dst = (isv ? CV : CK) + j * 8;
                    const f32x4 x0 = *(const f32x4*)src, x1 = *(const f32x4*)(src + 4);
                    v4u o; o.x = pk2(x0.x, x0.y); o.y = pk2(x0.z, x0.w); o.z = pk2(x1.x, x1.y); o.w = pk2(x1.z, x1.w); *(v4u*)dst = o;
                    if (!isv) {
                        float ss = (x0.x * x0.x + x0.y * x0.y) + (x0.z * x0.z + x0.w * x0.w) + (x1.x * x1.x + x1.y * x1.y) + (x1.z * x1.z + x1.w * x1.w);
                        ss += __shfl_xor(ss, 1); ss += __shfl_xor(ss, 2); ss += __shfl_xor(ss, 4);
#pragma unroll
                        for (int sh = 8; sh < 64; sh <<= 1) ss = fmaxf(ss, __shfl_xor(ss, sh));
                        if (!(ss >= 0.f)) ss = __builtin_inff();
                        if (lane == 0) atomicMax((unsigned*)(ws + WS_CKMAX) + (int)((j * 8 / (512 * 256)) & 3), __float_as_uint(ss)); } } }
}
__global__ void __launch_bounds__(512, 2) mk_fwd(Args a) {
    extern __shared__ __attribute__((aligned(16))) unsigned char lds_raw[];
    LAS unsigned char* lds = (LAS unsigned char*)lds_raw;
    cg::grid_group grid = cg::this_grid();
    const int G = gridDim.x, bx = blockIdx.x;
    const int NGW = G * 8;

    for (int u = threadIdx.x; u < 64; u += 512) ((LAS unsigned*)(lds + 131072))[u] = 0u;
    __syncthreads();
    XcdBarrier bar = xcd_barrier_post((unsigned*)a.p[17], (volatile LAS unsigned*)(lds + 131072 + 32));
    int ph = a.ph_lo;
    if (ph == 0) { if (PH_PRO) prologue_phase(a, lds, G, bx); ph = 1; if (ph < a.ph_hi) grid.sync(); }
    bool probe_again = false;
    for (; ph < a.ph_hi; ++ph) {
        int tid = threadIdx.x; asm volatile("" : "+v"(tid));
        const int lane = tid & 63; const int wave = __builtin_amdgcn_readfirstlane(tid >> 6); const int gw = bx * 8 + wave;
        int zz = 0; asm volatile("" : "+s"(zz));
        unsigned char* ws = (unsigned char*)a.p[17 + zz];
        float* out = (float*)a.p[16 + zz];
        float* mods = (float*)(ws + WS_MODS);
        float* ropec = (float*)(ws + WS_ROPE); float* ropes = ropec + 1024;
        bf16* XN = (bf16*)(ws + WS_XN); bf16* HB = (bf16*)(ws + WS_H);
        bf16* Qb = (bf16*)(ws + WS_Q); bf16* Kb = (bf16*)(ws + WS_K); bf16* Vb = (bf16*)(ws + WS_V); bf16* Ob = (bf16*)(ws + WS_O);
        bf16* CK = (bf16*)(ws + WS_CK); bf16* CV = (bf16*)(ws + WS_CV);
        {
            const int l = (ph - 1) / 10, sp = (ph - 1) % 10;
            const float* mods_l = mods + (size_t)l * 9 * NMODS;
            if (PH_MODLN && (sp == 0 || sp == 3 || sp == 7)) {
                const int sub = sp == 0 ? 0 : (sp == 3 ? 1 : 2);
                const float* ng = INP(8) + (size_t)(l * 3 + sub) * DM;
                const bool from_in = (l == 0 && sp == 0);
                for (int rep = 0; rep < ((PROBE_DUP & 1) ? 2 : 1); ++rep)
                for (int q4 = gw; q4 < MT / 4; q4 += NGW) { const int m = q4 * 4;
                    const int cond = m < MP ? 0 : 1 + ((m - MP) >> 12);
                    const float* sh = mods_l + (size_t)cond * NMODS + (3 * sub) * DM;
                    if (from_in) { const float* xrow = m < MP ? INP(0) + (size_t)m * DM : INP(1) + (size_t)(m - MP) * DM; modln_rows4(xrow, ng, sh, sh + DM, XN + (size_t)m * DM, lane); }
                    else modln_rows4_bf16((const bf16*)(ws + WS_HB) + (size_t)m * DM, ng, sh, sh + DM, XN + (size_t)m * DM, lane);
                }
            } else if (PH_FFIN && (sp == 1 || sp == 8)) {
                const int w = sp == 1 ? 0 : 1;
                pg8::Gemm g{XN, (const bf16*)(ws + WS_W1) + (size_t)(l * 2 + w) * 2 * DFF * DM, MT, 2 * DFF, DM}; pg8::StaticOrder S; S.init(MT, 2 * DFF, G, bx);
                pg8::EpiSwiglu E{HB};
                for (int rep = 0; rep < ((PROBE_DUP & 2) ? 2 : 1); ++rep)
                pg8::gemm_phase<pg8::EpiSwiglu, pg8::StaticOrder, true, true>(lds, g, S, E, tid);
            } else if (PH_RES && (sp == 2 || sp == 9 || sp == 6)) {
                const bool isff = sp != 6; const int w = sp == 9 ? 1 : 0;
                const bf16* A = isff ? HB : Ob; const int K = isff ? DFF : DM;
                const bf16* Bt = isff ? (const bf16*)(ws + WS_W2) + (size_t)(l * 2 + w) * DM * DFF : (const bf16*)(ws + WS_WO) + (size_t)l * DM * DM;
                pg8::Gemm g{A, Bt, MT, DM, K}; pg8::StaticOrder S; S.init(MT, DM, G, bx);
                const bool from_in = (l == 0 && sp == 2), last = (l == DEPTH - 1 && sp == 9);
                const float* rb0 = from_in ? INP(0) : nullptr; const long long radj = from_in ? (long long)((INP(1) - (size_t)MP * DM) - INP(0)) : 0ll;
                pg8::EpiResid E{rb0, radj, (bf16*)(ws + WS_HB), last ? out : nullptr, mods_l, (sp == 2 ? 2 : (sp == 6 ? 5 : 8)) * DM, isff ? 0.5f : 1.0f};
                pg8::gemm_phase<pg8::EpiResid, pg8::StaticOrder, true, true>(lds, g, S, E, tid);
            } else if (PH_QKV && sp == 4) {
                pg8::Gemm g{XN, (const bf16*)(ws + WS_WQKV) + (size_t)l * NQKV * DM, MT, NQKV, DM}; pg8::StaticOrder S; S.init(MT, NQKV, G, bx);
                pg8::EpiQKV E{Qb, out + OUT_NK + (size_t)l * 65536, INP(11) + l * 64, INP(12) + l * 64, ropec, 0.125f * 1.4426950408889634f};
                for (int rep = 0; rep < ((PROBE_DUP & 8) ? 2 : 1); ++rep)
                pg8::gemm_phase<pg8::EpiQKV, pg8::StaticOrder, true, true>(lds, g, S, E, tid);
            } else if (PH_ATT && sp == 5) {
                const bool full = (l & 1) == 0;
                for (int rep = 0; rep < ((PROBE_DUP & 4) ? 2 : 1); ++rep)
                attn_phase2(lds, Qb, Ob, Kb, Vb, CK, CV, INP(13), INP(11) + l * 64, INP(12) + l * 64, (const unsigned*)(ws + WS_CKMAX), l, full, bx, G, tid);
            }
        }
        if (ph + 1 < a.ph_hi) xcd_barrier(bar);
        if (PROBE_SKIP_RES((ph - 1) % 10)) { if (!probe_again) { probe_again = true; --ph; } else probe_again = false; }
    }
}

extern "C" void kernel_launch(void* const* d_in, const int* in_sizes, int n_in, void* d_out, int out_size, void* d_ws, size_t ws_size, hipStream_t stream) {
    static int grid = 0;
    if (grid == 0) {
        if (n_in != 16 || ws_size < WS_END) { fprintf(stderr, "kernel_launch: unexpected n_in %d / ws %zu\n", n_in, ws_size); grid = -1; return; }
        int dev = 0, cus = 0, per_cu = 0;
        hipGetDevice(&dev); hipDeviceGetAttribute(&cus, hipDeviceAttributeMultiprocessorCount, dev);
        if (hipFuncSetAttribute((const void*)mk_fwd, hipFuncAttributeMaxDynamicSharedMemorySize, LDS_BYTES) != hipSuccess) { fprintf(stderr, "kernel_launch: hipFuncSetAttribute failed\n"); grid = -1; return; }
        if (hipOccupancyMaxActiveBlocksPerMultiprocessor(&per_cu, (const void*)mk_fwd, 512, LDS_BYTES) != hipSuccess || per_cu < 1) { fprintf(stderr, "kernel_launch: occupancy query says %d\n", per_cu); per_cu = 1; }
        (void)hipGetLastError();
        grid = cus * 1;
    }
    if (grid < 0) return;
    if (hipMemsetAsync(d_ws, 0, 16384, stream) != hipSuccess) { fprintf(stderr, "kernel_launch: hipMemsetAsync failed\n"); return; }
    Args a{};
    for (int i = 0; i < 16; ++i) a.p[i] = d_in[i];
    a.p[16] = d_out; a.p[17] = d_ws;
#if MK_N_LAUNCHES == 1
    a.ph_lo = 0; a.ph_hi = NPHASES;
    { void* args[] = {&a}; hipError_t e = hipLaunchCooperativeKernel((const void*)mk_fwd, dim3(grid), dim3(512), args, LDS_BYTES, stream);
      if (e != hipSuccess) fprintf(stderr, "cooperative launch failed: %s (grid %d)\n", hipGetErrorString(e), grid); }
#else
    for (int ph = 0; ph < NPHASES; ++ph) { a.ph_lo = ph; a.ph_hi = ph + 1; void* args[] = {&a};
        hipError_t e = hipLaunchCooperativeKernel((const void*)mk_fwd, dim3(grid), dim3(512), args, LDS_BYTES, stream);
        if (e != hipSuccess) { fprintf(stderr, "launch %d failed: %s\n", ph, hipGetErrorString(e)); break; } }
#endif
}
```

```cpp
#include <hip/hip_runtime.h>
#include <hip/hip_cooperative_groups.h>
#include <cstdio>
#include <cstdint>
#include <cmath>
#include <type_traits>
namespace cg = cooperative_groups;
namespace pg8 {
#define PG8_LAS __attribute__((address_space(3)))
typedef unsigned short bf16_t;
typedef short bf16x8 __attribute__((ext_vector_type(8)));
typedef float f32x4 __attribute__((ext_vector_type(4)));
typedef unsigned u32x4 __attribute__((ext_vector_type(4)));
constexpr int BM = 256, BK = 64, HALF = 128, HTB = HALF * BK * 2  , STAGE_BYTES = 8 * HTB, NXCD = 8, WGM = 8;

__host__ __device__ __forceinline__ int lds_byte(int r, int c) { const int st = (r >> 4) * 2 + (c >> 5), rr = r & 15, cc = c & 31, ob = rr * 64 + cc * 2; return st * 1024 + (ob ^ (((ob >> 9) & 1) << 5)); }
__host__ __device__ __forceinline__ void stage_rc(int b, int& R, int& C) { const int st = b / 1024, sb = b % 1024, swz = sb ^ (((sb >> 9) & 1) << 5); R = (st >> 1) * 16 + swz / 64; C = (st & 1) * 32 + (swz % 64) / 2; }
__host__ __device__ __forceinline__ int perm32(int rho) { const int n = rho >> 4, i = rho & 15; return 8 * (i >> 2) + 4 * n + (i & 3); }

struct Unit { int pm, pn; };
struct Gemm { const bf16_t* A; const bf16_t* Bt; int M, N, K; };

struct StaticOrder {
    int nM, nN, nwg, G, c;
    __host__ __device__ void init(int M, int N, int G_, int c_) { nM = M / BM; nN = N / BM; nwg = nM * nN; G = G_; c = c_; }
    __host__ __device__ bool next(int i, Unit& u) const {
        const long L = (long)i * G + c; if (L >= nwg) return false;
        int wgid = (int)L; { const int q = nwg / NXCD, r = nwg % NXCD, xcd = wgid % NXCD, off = wgid / NXCD; wgid = (xcd < r ? xcd * (q + 1) : r * (q + 1) + (xcd - r) * q) + off; }
        const int nig = WGM * nN, gid = wgid / nig, fm = gid * WGM, gsz = (nM - fm) < WGM ? (nM - fm) : WGM;
        u.pm = fm + ((wgid % nig) % gsz); u.pn = (wgid % nig) / gsz; return true;
    }
    __device__ __forceinline__ void a_ready(const Unit&) const {}
    __device__ __forceinline__ void done(const Unit&) const {}
};

__device__ __forceinline__ unsigned cvt_pk_bf16(float lo, float hi) { unsigned r; asm volatile("v_cvt_pk_bf16_f32 %0, %1, %2" : "=v"(r) : "v"(lo), "v"(hi)); return r; }
constexpr int E_DM = 1024, E_DFF = 2816, E_MP = 8192;
__device__ __forceinline__ float silu_f(float g) { return g * __builtin_amdgcn_rcpf(1.0f + __builtin_amdgcn_exp2f(-1.4426950408889634f * g)); }
__device__ __forceinline__ float swiglu_folded(float gp, float up) { return (gp * up) * __builtin_amdgcn_rcpf(1.0f + __builtin_amdgcn_exp2f(gp)); }

struct EpiSwiglu {
    static constexpr bool PERM = true, AFTER_DRAIN = false;
    bf16_t* H;
    __device__ __forceinline__ void operator()(const f32x4 (&acc)[2][2][4][2], const Unit& u, int wr, int wc, int fr_, int fq_) const {
        int fr = fr_, fq = fq_; asm volatile("" : "+v"(fr), "+v"(fq));
        const int row0 = u.pm * BM + wr * 64 + fr; const int col0 = u.pn * 128 + wc * 32 + 8 * fq;
#pragma unroll
        for (int ai = 0; ai < 2; ++ai)
#pragma unroll
            for (int m = 0; m < 4; ++m) {
                bf16_t* rowp = H + (size_t)(row0 + ai * HALF + m * 16) * E_DFF + col0;
                const f32x4 g0 = acc[ai][0][m][0], g1 = acc[ai][0][m][1], u0 = acc[ai][1][m][0], u1 = acc[ai][1][m][1];
                u32x4 w;
                w.x = cvt_pk_bf16(swiglu_folded(g0[0], u0[0]), swiglu_folded(g0[1], u0[1])); w.y = cvt_pk_bf16(swiglu_folded(g0[2], u0[2]), swiglu_folded(g0[3], u0[3]));
                w.z = cvt_pk_bf16(swiglu_folded(g1[0], u1[0]), swiglu_folded(g1[1], u1[1])); w.w = cvt_pk_bf16(swiglu_folded(g1[2], u1[2]), swiglu_folded(g1[3], u1[3]));
                *(u32x4*)rowp = w;
            }
    }
};

typedef _Float16 h16x2 __attribute__((ext_vector_type(2)));
__device__ __forceinline__ unsigned pack_h2(float lo, float hi) { h16x2 r; r.x = (_Float16)__builtin_amdgcn_fmed3f(lo, -65504.f, 65504.f); r.y = (_Float16)__builtin_amdgcn_fmed3f(hi, -65504.f, 65504.f); return __builtin_bit_cast(unsigned, r); }
__device__ __forceinline__ float h2_lo(unsigned w) { return (float)__builtin_bit_cast(h16x2, w).x; }
__device__ __forceinline__ float h2_hi(unsigned w) { return (float)__builtin_bit_cast(h16x2, w).y; }
struct EpiResid {
    static constexpr bool PERM = true, AFTER_DRAIN = false;
    const float* xin; long long hi_adj; bf16_t* hb; float* outf; const float* mods_l; int gate_off; float coef;
    __device__ __forceinline__ void operator()(const f32x4 (&acc)[2][2][4][2], const Unit& u, int wr, int wc, int fr_, int fq_) const {
        int fr = fr_, fq = fq_; asm volatile("" : "+v"(fr), "+v"(fq));
        const int rowt = u.pm * BM; const int cond = rowt < E_MP ? 0 : 1 + ((rowt - E_MP) >> 12);
        const float* gp = mods_l + cond * 9216 + gate_off;
        const int col0 = u.pn * BM + wc * 32 + 8 * fq;
        f32x4 gv[2][2];
#pragma unroll
        for (int bj = 0; bj < 2; ++bj)
#pragma unroll
            for (int n = 0; n < 2; ++n) gv[bj][n] = *(const f32x4*)(gp + col0 + bj * HALF + n * 4) * coef;
        if (xin) {
            const float* base = xin + (rowt < E_MP ? 0ll : hi_adj) + (size_t)rowt * E_DM;
#pragma unroll
            for (int ai = 0; ai < 2; ++ai)
#pragma unroll
                for (int m = 0; m < 4; ++m) { const size_t off = (size_t)(ai * HALF + wr * 64 + m * 16 + fr) * E_DM + col0;
#pragma unroll
                    for (int bj = 0; bj < 2; ++bj) { const f32x4 b0 = *(const f32x4*)(base + off + bj * HALF), b1 = *(const f32x4*)(base + off + bj * HALF + 4);
                        const f32x4 y0 = b0 + gv[bj][0] * acc[ai][bj][m][0], y1 = b1 + gv[bj][1] * acc[ai][bj][m][1];
                        u32x4 w; w.x = pack_h2(y0[0], y0[1]); w.y = pack_h2(y0[2], y0[3]); w.z = pack_h2(y1[0], y1[1]); w.w = pack_h2(y1[2], y1[3]);
                        *(u32x4*)(hb + (size_t)rowt * E_DM + off + bj * HALF) = w; }
                    if (m & 1) asm volatile("" ::: "memory"); }
        } else {
            bf16_t* hp = hb + (size_t)rowt * E_DM;
#pragma unroll
            for (int ai = 0; ai < 2; ++ai) {
                u32x4 b[4][2];
#pragma unroll
                for (int m = 0; m < 4; ++m) { const size_t off = (size_t)(ai * HALF + wr * 64 + m * 16 + fr) * E_DM + col0;
#pragma unroll
                    for (int bj = 0; bj < 2; ++bj) b[m][bj] = *(const u32x4*)(hp + off + bj * HALF); }
#pragma unroll
                for (int m = 0; m < 4; ++m) { const size_t off = (size_t)(ai * HALF + wr * 64 + m * 16 + fr) * E_DM + col0;
#pragma unroll
                    for (int bj = 0; bj < 2; ++bj) { const u32x4 q = b[m][bj];
                        const f32x4 b0 = (f32x4){h2_lo(q.x), h2_hi(q.x), h2_lo(q.y), h2_hi(q.y)};
                        const f32x4 b1 = (f32x4){h2_lo(q.z), h2_hi(q.z), h2_lo(q.w), h2_hi(q.w)};
                        const f32x4 y0 = b0 + gv[bj][0] * acc[ai][bj][m][0], y1 = b1 + gv[bj][1] * acc[ai][bj][m][1];
                        if (outf) { float* o = outf + (size_t)rowt * E_DM + off + bj * HALF; *(f32x4*)o = y0; *(f32x4*)(o + 4) = y1; }
                        else { u32x4 w; w.x = pack_h2(y0[0], y0[1]); w.y = pack_h2(y0[2], y0[3]); w.z = pack_h2(y1[0], y1[1]); w.w = pack_h2(y1[2], y1[3]); *(u32x4*)(hp + off + bj * HALF) = w; } } }
                asm volatile("" ::: "memory"); }
        }
    }
};

struct EpiQKV {
    static constexpr bool PERM = false, AFTER_DRAIN = false;
    static constexpr long long KOFF = 80ll * 1048576 / 2, VOFF = 100ll * 1048576 / 2, NVOFF = 8388608ll;
    bf16_t* Q; float* newk; const float* qg; const float* kg; const float* ropec; float qscale;
    __device__ __forceinline__ void operator()(const f32x4 (&acc)[2][2][4][2], const Unit& u, int wr, int wc, int fr_, int fq_) const {
        int fr = fr_, fq = fq_; asm volatile("" : "+v"(fr), "+v"(fq));
        const int rowt = u.pm * BM; const bool lat = rowt >= E_MP; const int pn = u.pn;
        f32x4 gv[2][2];
#pragma unroll
        for (int bj = 0; bj < 2; ++bj)
#pragma unroll
            for (int n = 0; n < 2; ++n) { const f32x4 a = *(const f32x4*)(qg + 32 * bj + 16 * n + 4 * fq) * qscale, b = *(const f32x4*)(kg + 32 * bj + 16 * n + 4 * fq);
                gv[bj][n] = pn < 4 ? a : b; }
        const long long kvoff = pn == 4 ? KOFF : VOFF; const long long nkoff = pn == 4 ? 0ll : NVOFF;
#pragma unroll
        for (int ai = 0; ai < 2; ++ai)
#pragma unroll
            for (int m = 0; m < 4; ++m) {
                const int r = rowt + ai * HALF + wr * 64 + m * 16 + fr;
                f32x4 v[2][2];
#pragma unroll
                for (int bj = 0; bj < 2; ++bj)
#pragma unroll
                    for (int n = 0; n < 2; ++n) v[bj][n] = acc[ai][bj][m][n];
                if (pn < 5) {
                    float ss = 0.f;
#pragma unroll
                    for (int bj = 0; bj < 2; ++bj)
#pragma unroll
                        for (int n = 0; n < 2; ++n) { const f32x4 x = v[bj][n]; ss += (x[0] * x[0] + x[1] * x[1]) + (x[2] * x[2] + x[3] * x[3]); }
                    ss += __shfl_xor(ss, 16); ss += __shfl_xor(ss, 32);
                    const float rstd = __builtin_amdgcn_rsqf(ss * (1.0f / 64.0f) + 1e-6f);
#pragma unroll
                    for (int bj = 0; bj < 2; ++bj)
#pragma unroll
                        for (int n = 0; n < 2; ++n) v[bj][n] = v[bj][n] * rstd * gv[bj][n];
                }
                if (!lat && pn >= 4) {
                    float* dst = newk + nkoff + (size_t)(r >> 8) * (4 * 65536) + (size_t)(r & 255) * 256 + wc * 64 + 4 * fq;
#pragma unroll
                    for (int bj = 0; bj < 2; ++bj)
#pragma unroll
                        for (int n = 0; n < 2; ++n) *(f32x4*)(dst + 32 * bj + 16 * n) = v[bj][n];
                }
                if (lat && pn < 5) {
                    const int t = (r - E_MP) & 4095;
#pragma unroll
                    for (int bj = 0; bj < 2; ++bj) { const int pos = bj ? (t & 63) : (t >> 6);
                        const f32x4 cs = *(const f32x4*)(ropec + pos * 16 + 4 * fq), sn = *(const f32x4*)(ropec + 1024 + pos * 16 + 4 * fq);
                        const f32x4 x1 = v[bj][0], x2 = v[bj][1]; v[bj][0] = x1 * cs - x2 * sn; v[bj][1] = x2 * cs + x1 * sn; }
                }
                const long long doff = (pn < 4) ? (long long)r * 1024 + (4 * pn + wc) * 64 : kvoff + (long long)r * 256 + wc * 64;
                bf16_t* dst = Q + doff + 4 * fq;
#pragma unroll
                for (int bj = 0; bj < 2; ++bj)
#pragma unroll
                    for (int n = 0; n < 2; ++n) { typedef unsigned u32x2 __attribute__((ext_vector_type(2))); u32x2 w; w.x = cvt_pk_bf16(v[bj][n][0], v[bj][n][1]); w.y = cvt_pk_bf16(v[bj][n][2], v[bj][n][3]);
                        *(u32x2*)(dst + 32 * bj + 16 * n) = w; }
                asm volatile("" ::: "memory");
            }
    }
};
template <class Epi, class Sched, bool ALIGN_EPI = false, bool SP2 = false>
__device__ __forceinline__ void gemm_phase(PG8_LAS unsigned char* lds, const Gemm g, const Sched& S, const Epi& E, const int tid) {
    const int wid = __builtin_amdgcn_readfirstlane(tid >> 6), lane = tid & 63, wr = wid >> 2, wc = wid & 3, fr = lane & 15, fq = lane >> 4;
    const int K = g.K, nt = K / BK;
    unsigned voffA[2], voffB[2];
#pragma unroll
    for (int i = 0; i < 2; ++i) { int R, C; stage_rc(tid * 16 + i * 8192, R, C); const int Rb = Epi::PERM ? ((R & ~31) + perm32(R & 31)) : R;
        voffA[i] = (unsigned)(R * K + C) * 2u; voffB[i] = (unsigned)(Rb * K + C) * 2u; }
    const size_t kstep = (size_t)(BK * 2);
    const size_t hstep = (size_t)HALF * K * 2;
    const size_t tstep = 2 * hstep;
    const unsigned ldsw = (unsigned)wid * 1024u;
    const int aoff = lds_byte(wr * 64 + fr, fq * 8), boff = lds_byte(wc * 32 + fr, fq * 8);
#define PG8_SA(b, h) (((b) * 2 + (h)) * HTB)
#define PG8_SB(b, h) ((4 + (b) * 2 + (h)) * HTB)
#define PG8_STAGE(bufoff, gbase, voff) do { _Pragma("unroll") for (int _i = 0; _i < 2; ++_i) \
        __builtin_amdgcn_global_load_lds((const unsigned*)((const char*)(gbase) + (voff)[_i]), (PG8_LAS unsigned*)(lds + (bufoff) + ldsw + _i * 8192), 16, 0, 0); } while (0)
#define PG8_LDA(dst, b, h) do { _Pragma("unroll") for (int m = 0; m < 4; ++m) _Pragma("unroll") for (int k = 0; k < 2; ++k) dst[m][k] = *(const PG8_LAS bf16x8*)(lds + PG8_SA(b, h) + aoff + m * 2048 + k * 1024); } while (0)
#define PG8_LDB(dst, b, h) do { _Pragma("unroll") for (int n = 0; n < 2; ++n) _Pragma("unroll") for (int k = 0; k < 2; ++k) dst[n][k] = *(const PG8_LAS bf16x8*)(lds + PG8_SB(b, h) + boff + n * 2048 + k * 1024); } while (0)
#define PG8_MMA(ai, bj, At, Bt) do { __builtin_amdgcn_s_setprio(1); _Pragma("unroll") for (int m = 0; m < 4; ++m) _Pragma("unroll") for (int n = 0; n < 2; ++n) _Pragma("unroll") for (int k = 0; k < 2; ++k) \
        acc[ai][bj][m][n] = __builtin_amdgcn_mfma_f32_16x16x32_bf16(Bt[n][k], At[m][k], acc[ai][bj][m][n], 0, 0, 0); __builtin_amdgcn_s_setprio(0); } while (0)
#define PG8_WAIT_V(n) asm volatile("s_waitcnt vmcnt(" #n ")" ::: "memory")
#define PG8_WAIT_L(n) asm volatile("s_waitcnt lgkmcnt(" #n ")" ::: "memory")
#define PG8_BAR __builtin_amdgcn_s_barrier()
#define PG8_SCHED __builtin_amdgcn_sched_barrier(0)
    Unit cur, nxt; int ui = 0;
    if (!S.next(0, cur)) return;
    f32x4 acc[2][2][4][2];
#pragma unroll
    for (int a = 0; a < 2; ++a)
#pragma unroll
        for (int b = 0; b < 2; ++b)
#pragma unroll
            for (int m = 0; m < 4; ++m)
#pragma unroll
                for (int n = 0; n < 2; ++n) acc[a][b][m][n] = (f32x4){0.f, 0.f, 0.f, 0.f};
    bf16x8 At[4][2], B0[2][2], B1[2][2];
    const char* cA = (const char*)g.A + (size_t)cur.pm * tstep; const char* cB = (const char*)g.Bt + (size_t)cur.pn * tstep;
    S.a_ready(cur);
    if constexpr (SP2) {
        PG8_STAGE(PG8_SB(0, 0), cB, voffB); PG8_STAGE(PG8_SB(0, 1), cB + hstep, voffB); PG8_STAGE(PG8_SA(0, 0), cA, voffA); PG8_STAGE(PG8_SA(0, 1), cA + hstep, voffA);
        if (wr == 1) PG8_BAR;
        PG8_WAIT_V(2); PG8_BAR;
        PG8_STAGE(PG8_SB(1, 0), cB + kstep, voffB); PG8_STAGE(PG8_SA(1, 0), cA + kstep, voffA); PG8_STAGE(PG8_SB(1, 1), cB + hstep + kstep, voffB);
        PG8_WAIT_V(6); PG8_BAR;
    } else {
        PG8_STAGE(PG8_SB(0, 0), cB, voffB); PG8_STAGE(PG8_SA(0, 0), cA, voffA); PG8_STAGE(PG8_SB(0, 1), cB + hstep, voffB); PG8_STAGE(PG8_SA(0, 1), cA + hstep, voffA);
        if (wr == 1) PG8_BAR;
        PG8_WAIT_V(4); PG8_BAR;
        PG8_STAGE(PG8_SB(1, 0), cB + kstep, voffB); PG8_STAGE(PG8_SA(1, 0), cA + kstep, voffA); PG8_STAGE(PG8_SB(1, 1), cB + hstep + kstep, voffB);
        PG8_WAIT_V(6); PG8_BAR;
    }
    for (;;) {
        const bool has_next = S.next(ui + 1, nxt);
        const char* nA = has_next ? (const char*)g.A + (size_t)nxt.pm * tstep : cA; const char* nB = has_next ? (const char*)g.Bt + (size_t)nxt.pn * tstep : cB;
        for (int t = 0; t < nt; t += 2) {
            const bool last = (t == nt - 2);
            const char* a1 = cA + (size_t)(t + 1) * kstep;
            const char* a2 = last ? nA : cA + (size_t)(t + 2) * kstep; const char* b2 = last ? nB : cB + (size_t)(t + 2) * kstep;
            const char* a3 = a2 + kstep; const char* b3 = b2 + kstep;
            if (last && has_next) S.a_ready(nxt);
            if constexpr (SP2) {
            PG8_LDB(B0, 0, 0); PG8_LDB(B1, 0, 1); PG8_SCHED; PG8_LDA(At, 0, 0); PG8_STAGE(PG8_SA(1, 1), a1 + hstep, voffA);
            PG8_WAIT_V(8); PG8_WAIT_L(0); PG8_BAR; PG8_MMA(0, 0, At, B0); PG8_MMA(0, 1, At, B1); PG8_BAR; PG8_SCHED;
            PG8_LDA(At, 0, 1); PG8_STAGE(PG8_SB(0, 0), b2, voffB); PG8_STAGE(PG8_SB(0, 1), b2 + hstep, voffB); PG8_STAGE(PG8_SA(0, 0), a2, voffA);
            PG8_WAIT_V(8); PG8_WAIT_L(0); PG8_BAR; PG8_MMA(1, 0, At, B0); PG8_MMA(1, 1, At, B1); PG8_BAR; PG8_SCHED;
            PG8_LDB(B0, 1, 0); PG8_LDB(B1, 1, 1); PG8_SCHED; PG8_LDA(At, 1, 0); PG8_STAGE(PG8_SA(0, 1), a2 + hstep, voffA);
            PG8_WAIT_V(8); PG8_WAIT_L(0); PG8_BAR; PG8_MMA(0, 0, At, B0); PG8_MMA(0, 1, At, B1); PG8_BAR; PG8_SCHED;
            PG8_LDA(At, 1, 1); PG8_STAGE(PG8_SB(1, 0), b3, voffB); PG8_STAGE(PG8_SB(1, 1), b3 + hstep, voffB); PG8_STAGE(PG8_SA(1, 0), a3, voffA);
            PG8_WAIT_V(8); PG8_WAIT_L(0); PG8_BAR; PG8_MMA(1, 0, At, B0); PG8_MMA(1, 1, At, B1); PG8_BAR; PG8_SCHED;
            } else {
            PG8_LDB(B0, 0, 0); PG8_SCHED; PG8_LDA(At, 0, 0); PG8_STAGE(PG8_SA(1, 1), a1 + hstep, voffA);
            PG8_WAIT_L(8); PG8_BAR; PG8_WAIT_L(0); PG8_MMA(0, 0, At, B0); PG8_BAR; PG8_SCHED;
            PG8_LDB(B1, 0, 1); PG8_STAGE(PG8_SB(0, 0), b2, voffB);
            PG8_BAR; PG8_WAIT_L(0); PG8_MMA(0, 1, At, B1); PG8_BAR;
            PG8_LDA(At, 0, 1); PG8_STAGE(PG8_SA(0, 0), a2, voffA);
            PG8_BAR; PG8_WAIT_L(0); PG8_MMA(1, 0, At, B0); PG8_BAR; PG8_SCHED;
            PG8_STAGE(PG8_SB(0, 1), b2 + hstep, voffB);
            PG8_WAIT_V(6); PG8_BAR; PG8_MMA(1, 1, At, B1); PG8_BAR;
            PG8_LDB(B0, 1, 0); PG8_SCHED; PG8_LDA(At, 1, 0); PG8_STAGE(PG8_SA(0, 1), a2 + hstep, voffA);
            PG8_WAIT_L(8); PG8_BAR; PG8_WAIT_L(0); PG8_MMA(0, 0, At, B0); PG8_BAR; PG8_SCHED;
            PG8_LDB(B1, 1, 1); PG8_STAGE(PG8_SB(1, 0), b3, voffB);
            PG8_BAR; PG8_WAIT_L(0); PG8_MMA(0, 1, At, B1); PG8_BAR;
            PG8_LDA(At, 1, 1); PG8_STAGE(PG8_SA(1, 0), a3, voffA);
            PG8_BAR; PG8_WAIT_L(0); PG8_MMA(1, 0, At, B0); PG8_BAR; PG8_SCHED;
            PG8_STAGE(PG8_SB(1, 1), b3 + hstep, voffB);
            PG8_WAIT_V(6); PG8_BAR; PG8_MMA(1, 1, At, B1); PG8_BAR;
            }
        }
        if constexpr (ALIGN_EPI) { if (wr == 0) PG8_BAR; }
        if constexpr (!Epi::AFTER_DRAIN) { E(acc, cur, wr, wc, fr, fq); S.done(cur); }
        if (!has_next) break;
#pragma unroll
        for (int a = 0; a < 2; ++a)
#pragma unroll
            for (int b = 0; b < 2; ++b)
#pragma unroll
                for (int m = 0; m < 4; ++m)
#pragma unroll
                    for (int n = 0; n < 2; ++n) acc[a][b][m][n] = (f32x4){0.f, 0.f, 0.f, 0.f};
        cur = nxt; cA = nA; cB = nB; ++ui;
        if constexpr (ALIGN_EPI) { if (wr == 1) PG8_BAR; }
    }
    PG8_WAIT_V(0);
    if constexpr (!ALIGN_EPI) { if (wr == 0) PG8_BAR; }
    PG8_BAR;
    if constexpr (Epi::AFTER_DRAIN) { E.fused(acc, cur, wr, wc, fr, fq, lds, wid, lane); S.done(cur); }
#undef PG8_SA
#undef PG8_SB
#undef PG8_STAGE
#undef PG8_LDA
#undef PG8_LDB
#undef PG8_MMA
#undef PG8_WAIT_V
#undef PG8_WAIT_L
#undef PG8_BAR
#undef PG8_SCHED
}
}
#define LAS __attribute__((address_space(3)))
typedef unsigned short bf16;
typedef unsigned v4u __attribute__((ext_vector_type(4)));
typedef unsigned v2u __attribute__((ext_vector_type(2)));
typedef float f32x4 __attribute__((ext_vector_type(4)));
typedef float f32x16 __attribute__((ext_vector_type(16)));
typedef short bf16x8 __attribute__((ext_vector_type(8)));
typedef short s16x4 __attribute__((ext_vector_type(4)));

constexpr int DM = 1024, NH = 16, NKV = 4, HD = 64, DFF = 2816, DEPTH = 4, NQKV = 1536;
constexpr int MP = 8192, MS = 32768, MT = 40960, LSEQ = 4096, PAST = 512, CSEQ = 256;
constexpr int NMODS = 9216;
constexpr size_t MiB = 1u << 20;
constexpr size_t WS_CKMAX = 15360;
constexpr size_t WS_MODS = 1 * MiB, WS_ROPE = 3 * MiB, WS_WQKV = 4 * MiB, WS_WO = 16 * MiB, WS_W1 = 24 * MiB, WS_W2 = 112 * MiB,
                 WS_CK = 156 * MiB, WS_CV = 164 * MiB, WS_XN = 172 * MiB, WS_H = 252 * MiB,
                 WS_Q = 252 * MiB, WS_K = 332 * MiB, WS_V = 352 * MiB, WS_O = 372 * MiB, WS_HB = 472 * MiB, WS_END = 552 * MiB;
constexpr size_t OUT_NK = (size_t)MT * DM, OUT_NV = OUT_NK + (size_t)32 * 4 * 256 * 256;
static_assert(WS_K - WS_Q == 80 * MiB && WS_V - WS_Q == 100 * MiB && OUT_NV - OUT_NK == 8388608, "EpiQKV offsets");
constexpr int LDS_BYTES = 147456;
constexpr int NPHASES = 1 + 10 * DEPTH;
#ifndef PH_MASK
#define PH_MASK 63
#endif
#define PH_PRO ((PH_MASK) & 1)
#define PH_MODLN ((PH_MASK) & 2)
#define PH_FFIN ((PH_MASK) & 4)
#define PH_RES ((PH_MASK) & 8)
#define PH_QKV ((PH_MASK) & 16)
#define PH_ATT ((PH_MASK) & 32)
#ifndef PROBE_SKIP_RES
#define PROBE_SKIP_RES(sp) false
#endif
#ifndef PROBE_DUP
#define PROBE_DUP 0
#endif
#ifndef MK_N_LAUNCHES
#define MK_N_LAUNCHES 1
#endif

__device__ __forceinline__ unsigned f2bf(float f) { unsigned u = __builtin_bit_cast(unsigned, f); return (u + 0x7fffu + ((u >> 16) & 1u)) >> 16; }
__device__ __forceinline__ unsigned pk2(float lo, float hi) { return f2bf(lo) | (f2bf(hi) << 16); }
__device__ __forceinline__ float wave_sum(float v) {
#pragma unroll
    for (int o = 1; o < 64; o <<= 1) v += __shfl_xor(v, o);
    return v;
}

#define XB_TMO      128
#define XB_XCNT(j)  (256  + 64 * (j))
#define XB_XSUB(j)  (1280 + 64 * (j))
#define XB_XGEN(j)  (2304 + 64 * (j))
#define XB_TOP      3328
#define XB_TOPGEN   3392
#define XCD_BAR_WORDS 3456
#define XB_SPIN_CAP (1u << 18)

__device__ __forceinline__ unsigned xb_ld(unsigned* p)              { return __hip_atomic_load(p, __ATOMIC_RELAXED, __HIP_MEMORY_SCOPE_AGENT); }
__device__ __forceinline__ unsigned xb_add(unsigned* p, unsigned v) { return __hip_atomic_fetch_add(p, v, __ATOMIC_RELAXED, __HIP_MEMORY_SCOPE_AGENT); }
__device__ __forceinline__ unsigned xb_xcc_id() { return (unsigned)__builtin_amdgcn_s_getreg((3 << 11) | 20) & 0xFu; }
#define XB_SPIN(cond, bar) do { unsigned _sp = 0; while (cond) { __builtin_amdgcn_s_sleep(1); \
    if ((++_sp & 255u) == 0u) { if (xb_ld(&(bar)[XB_TMO])) break; if (_sp > XB_SPIN_CAP) { atomicAdd(&(bar)[XB_TMO], 1u); break; } } } } while (0)

struct XcdBarrier {
    unsigned* bar; unsigned x;
    volatile LAS unsigned* st;
};

__device__ __forceinline__ XcdBarrier xcd_barrier_post(unsigned* bar, volatile LAS unsigned* st) {
    XcdBarrier b; b.bar = bar; b.x = xb_xcc_id(); b.st = st;
    if (threadIdx.x == 0) (void)xb_add(&bar[XB_XCNT(b.x)], 1u);
    return b;
}
__device__ __forceinline__ void xcd_barrier_complete(unsigned* bar, unsigned x, unsigned& nloc, unsigned& nx) {
    const unsigned G = gridDim.x * gridDim.y * gridDim.z;
    unsigned sum, cnt, mine, sp = 0u;
    for (;;) {
        sum = 0u; cnt = 0u; mine = 0u;
#pragma unroll
        for (unsigned j = 0; j < 16; ++j) { const unsigned c = xb_ld(&bar[XB_XCNT(j)]); sum += c; cnt += (c > 0u) ? 1u : 0u; mine = (j == x) ? c : mine; }
        if (sum == G) break;
        __builtin_amdgcn_s_sleep(1);
        if ((++sp & 255u) == 0u) { if (xb_ld(&bar[XB_TMO])) break; if (sp > XB_SPIN_CAP) { atomicAdd(&bar[XB_TMO], 1u); break; } }
    }
    nloc = mine > 0u ? mine : 1u; nx = cnt > 0u ? cnt : 1u;
}

__device__ __forceinline__ void xcd_barrier(const XcdBarrier& b) {
    asm volatile("s_waitcnt vmcnt(0)" ::: "memory");
    __syncthreads();
    if (threadIdx.x == 0) {
        unsigned* bar = b.bar;
        __builtin_amdgcn_s_waitcnt(0);
        unsigned nloc = b.st[0], nx = b.st[1];
        if (nloc == 0u) { xcd_barrier_complete(bar, b.x, nloc, nx); b.st[0] = nloc; b.st[1] = nx; }
        const unsigned old = xb_add(&bar[XB_XSUB(b.x)], 1u);
        const unsigned gen = old / nloc;
        if (old + 1u == (gen + 1u) * nloc) {
            __builtin_amdgcn_fence(__ATOMIC_RELEASE, "agent");
            asm volatile("s_waitcnt vmcnt(0)" ::: "memory");
            const unsigned og = xb_add(&bar[XB_TOP], 1u);
            const unsigned tg = og / nx;
            if (og + 1u == (tg + 1u) * nx) xb_add(&bar[XB_TOPGEN], 1u);
            else XB_SPIN(xb_ld(&bar[XB_TOPGEN]) == tg, bar);
            __builtin_amdgcn_fence(__ATOMIC_ACQUIRE, "agent");
            xb_add(&bar[XB_XGEN(b.x)], 1u);
            asm volatile("s_waitcnt vmcnt(0)" ::: "memory");
        } else {
            XB_SPIN(xb_ld(&bar[XB_XGEN(b.x)]) == gen, bar);
            __builtin_amdgcn_fence(__ATOMIC_ACQUIRE, "agent");
            asm volatile("s_waitcnt vmcnt(0)" ::: "memory");
        }
    }
    __syncthreads();
}

__device__ __forceinline__ void p0_transpose_item(const float* W, int K, int N, bf16* WT, int mode, LAS float* scr, int item, int lane) {
    const int nblk = N / 32, kb = item / nblk, nb = item % nblk, k0 = 64 * kb, n0 = 32 * nb;
#pragma unroll 8
    for (int i = 0; i < 32; ++i) { const int kk = 2 * i + (lane >> 5); scr[kk * 33 + (lane & 31)] = W[(size_t)(k0 + kk) * N + n0 + (lane & 31)]; }
    asm volatile("s_waitcnt lgkmcnt(0)" ::: "memory");
    const int c = lane & 7;
#pragma unroll
    for (int j = 0; j < 4; ++j) { const int n = (lane >> 3) + 8 * j; const LAS float* s = scr + (8 * c) * 33 + n;
        const int col = n0 + n; int drow = col;
        if (mode == 1) { const int up = col >= DFF ? 1 : 0; const int jj = col - up * DFF; drow = (jj >> 7) * 256 + up * 128 + (jj & 127); }
        else if (mode == 2) { drow = (col & ~255) + ((col >> 5) & 1) * 128 + ((col >> 6) & 3) * 32 + (col & 31); }
        const float wsc = mode == 1 ? (col >= DFF ? -0.6931471805599453f : -1.4426950408889634f) : 1.0f;
        v4u o; o.x = pk2(s[0 * 33] * wsc, s[1 * 33] * wsc); o.y = pk2(s[2 * 33] * wsc, s[3 * 33] * wsc); o.z = pk2(s[4 * 33] * wsc, s[5 * 33] * wsc); o.w = pk2(s[6 * 33] * wsc, s[7 * 33] * wsc);
        *(v4u*)(WT + (size_t)drow * K + k0 + 8 * c) = o; }
    asm volatile("s_waitcnt lgkmcnt(0)" ::: "memory");
}

__device__ __forceinline__ void p0_mods_unit(LAS unsigned char* lds, const float* c, const float* cctx, const float* wmod_l, const float* bmod_l, float* mods_l, int chunk, int tid) {
    LAS float* sc = (LAS float*)lds;
    LAS float* red = (LAS float*)(lds + 36864);
    for (int i = tid; i < 9 * 1024; i += 512) { const int cond = i >> 10, k = i & 1023; const float x = cond == 0 ? cctx[k] : c[(cond - 1) * 1024 + k]; sc[i] = x / (1.0f + __expf(-x)); }
    __syncthreads();
    const int kg = tid >> 7, tc = tid & 127; const int col = chunk * 512 + tc * 4;
    f32x4 acc[9];
#pragma unroll
    for (int q = 0; q < 9; ++q) acc[q] = (f32x4){0.f, 0.f, 0.f, 0.f};
#pragma unroll 4
    for (int k = kg * 256; k < kg * 256 + 256; ++k) { const f32x4 w = *(const f32x4*)(wmod_l + (size_t)k * NMODS + col);
#pragma unroll
        for (int q = 0; q < 9; ++q) acc[q] += w * sc[q * 1024 + k]; }
#pragma unroll
    for (int q = 0; q < 9; ++q) *(LAS f32x4*)(red + (kg * 9 + q) * 512 + tc * 4) = acc[q];
    __syncthreads();
    for (int i = tid; i < 9 * 512; i += 512) { const int q = i >> 9, j = i & 511;
        const float s = (red[(0 * 9 + q) * 512 + j] + red[(1 * 9 + q) * 512 + j]) + (red[(2 * 9 + q) * 512 + j] + red[(3 * 9 + q) * 512 + j]) + bmod_l[chunk * 512 + j];
        mods_l[q * NMODS + chunk * 512 + j] = s; }
    __syncthreads();
}

__device__ __forceinline__ void p0_rope(float* ct, float* st, int tid) {
    for (int i = tid; i < 1024; i += 512) { const int pos = i >> 4, f = i & 15;
        double fr = 1.0; for (int q = 0; q < f; ++q) fr *= 0.5623413251903491;
        const float ang = (float)pos * (float)fr;
        const double a = (double)ang; const double n = __builtin_rint(a * 0.6366197723675814); const double r = a - n * 1.5707963267948966;
        const double r2 = r * r;
        double sp = r * (1.0 + r2 * (-1.0 / 6 + r2 * (1.0 / 120 + r2 * (-1.0 / 5040 + r2 * (1.0 / 362880 + r2 * (-1.0 / 39916800 + r2 * (1.0 / 6227020800.0)))))));
        double cp = 1.0 + r2 * (-0.5 + r2 * (1.0 / 24 + r2 * (-1.0 / 720 + r2 * (1.0 / 40320 + r2 * (-1.0 / 3628800 + r2 * (1.0 / 479001600.0 + r2 * (-1.0 / 87178291200.0)))))));
        const int qd = ((int)n) & 3; double s, cc;
        if (qd == 0) { s = sp; cc = cp; } else if (qd == 1) { s = cp; cc = -sp; } else if (qd == 2) { s = -sp; cc = -cp; } else { s = -cp; cc = sp; }
        ct[i] = (float)cc; st[i] = (float)s; }
}

__device__ __forceinline__ void modln_rows4(const float* xrow, const float* ng, const float* sh, const float* sc, bf16* orow, int lane) {
    const f32x4* xr = (const f32x4*)xrow + lane;
    f32x4 v[4][4]; float s[4];
#pragma unroll
    for (int r = 0; r < 4; ++r)
#pragma unroll
        for (int j = 0; j < 4; ++j) v[r][j] = xr[r * 256 + 64 * j];
#pragma unroll
    for (int r = 0; r < 4; ++r) { float t = 0.f;
#pragma unroll
        for (int j = 0; j < 4; ++j) t += (v[r][j].x * v[r][j].x + v[r][j].y * v[r][j].y) + (v[r][j].z * v[r][j].z + v[r][j].w * v[r][j].w);
        s[r] = t; }
#pragma unroll
    for (int o = 1; o < 64; o <<= 1) {
#pragma unroll
        for (int r = 0; r < 4; ++r) s[r] += __shfl_xor(s[r], o); }
    unsigned long long* o8 = (unsigned long long*)orow + lane;
#pragma unroll
    for (int j = 0; j < 4; ++j) { const f32x4 g = ((const f32x4*)ng)[lane + 64 * j], a = ((const f32x4*)sc)[lane + 64 * j] + 1.0f, b = ((const f32x4*)sh)[lane + 64 * j];
        const f32x4 ga = g * a;
#pragma unroll
        for (int r = 0; r < 4; ++r) { const float rstd = 1.0f / sqrtf(s[r] * (1.f / DM) + 1e-6f);
            const f32x4 y = (v[r][j] * rstd) * ga + b;
            o8[r * 256 + 64 * j] = (unsigned long long)pk2(y.x, y.y) | ((unsigned long long)pk2(y.z, y.w) << 32); } }
}

__device__ __forceinline__ void modln_rows4_bf16(const bf16* hrow, const float* ng, const float* sh, const float* sc, bf16* orow, int lane) {
    const v4u* xr = (const v4u*)hrow + lane;
    v4u q[4][2]; float s[4];
#pragma unroll
    for (int r = 0; r < 4; ++r)
#pragma unroll
        for (int j = 0; j < 2; ++j) q[r][j] = xr[r * 128 + 64 * j];
#define BF_LO(w) pg8::h2_lo(w)
#define BF_HI(w) pg8::h2_hi(w)
#pragma unroll
    for (int r = 0; r < 4; ++r) { float t = 0.f;
#pragma unroll
        for (int j = 0; j < 2; ++j) { const v4u w = q[r][j];
            t += (BF_LO(w.x) * BF_LO(w.x) + BF_HI(w.x) * BF_HI(w.x)) + (BF_LO(w.y) * BF_LO(w.y) + BF_HI(w.y) * BF_HI(w.y)) + (BF_LO(w.z) * BF_LO(w.z) + BF_HI(w.z) * BF_HI(w.z)) + (BF_LO(w.w) * BF_LO(w.w) + BF_HI(w.w) * BF_HI(w.w)); }
        s[r] = t; }
#pragma unroll
    for (int o = 1; o < 64; o <<= 1) {
#pragma unroll
        for (int r = 0; r < 4; ++r) s[r] += __shfl_xor(s[r], o); }
    v4u* o16 = (v4u*)orow + lane;
#pragma unroll
    for (int j = 0; j < 2; ++j) {
        const f32x4 g0 = ((const f32x4*)ng)[2 * lane + 128 * j], g1 = ((const f32x4*)ng)[2 * lane + 128 * j + 1];
        const f32x4 a0 = ((const f32x4*)sc)[2 * lane + 128 * j] + 1.0f, a1 = ((const f32x4*)sc)[2 * lane + 128 * j + 1] + 1.0f;
        const f32x4 b0 = ((const f32x4*)sh)[2 * lane + 128 * j], b1 = ((const f32x4*)sh)[2 * lane + 128 * j + 1];
        const f32x4 ga0 = g0 * a0, ga1 = g1 * a1;
#pragma unroll
        for (int r = 0; r < 4; ++r) { const float rstd = 1.0f / sqrtf(s[r] * (1.f / DM) + 1e-6f); const v4u w = q[r][j];
            const f32x4 x0 = (f32x4){BF_LO(w.x), BF_HI(w.x), BF_LO(w.y), BF_HI(w.y)}, x1 = (f32x4){BF_LO(w.z), BF_HI(w.z), BF_LO(w.w), BF_HI(w.w)};
            const f32x4 y0 = (x0 * rstd) * ga0 + b0, y1 = (x1 * rstd) * ga1 + b1;
            v4u o; o.x = pk2(y0.x, y0.y); o.y = pk2(y0.z, y0.w); o.z = pk2(y1.x, y1.y); o.w = pk2(y1.z, y1.w);
            o16[r * 128 + 64 * j] = o; } }
#undef BF_LO
#undef BF_HI
}

__device__ __forceinline__ int crow(int r, int hi) { return (r & 3) + 8 * (r >> 2) + 4 * hi; }
__device__ __forceinline__ float xmax32(float v) {
    auto rr = __builtin_amdgcn_permlane32_swap(__float_as_uint(v), __float_as_uint(v), false, false);
    return fmaxf(__uint_as_float(rr[0]), __uint_as_float(rr[1]));
}
__device__ __forceinline__ float xsum32(float v) {
    auto rr = __builtin_amdgcn_permlane32_swap(__float_as_uint(v), __float_as_uint(v), false, false);
    return __uint_as_float(rr[0]) + __uint_as_float(rr[1]);
}
constexpr float ATT_THR = 6.0f;
__device__ __forceinline__ void attn_decode(int u, int l, bool full, const bf16* Qb, bf16* Ob, const bf16* Kb, const bf16* Vb, const bf16* CK, const bf16* CV, const float* sinkp,
                                            const bf16*& Qu, bf16*& Ou, const bf16*& K0, const bf16*& V0, int& n0, const bf16*& K1, const bf16*& V1, int& n1, int& qrel0, bool& win, float& sink2) {
    int h;
    if (u < 2048) { const int b = u >> 8; const int c8 = u & 255; const int xcd = c8 & 7, slot = (xcd & 1) * 32 + (c8 >> 3);
        const int kvh = xcd >> 1; h = kvh * 4 + (slot >> 4); const int qb = slot & 15; const size_t rowb = (size_t)MP + (size_t)b * LSEQ; const int q0 = qb * 256;
        Qu = Qb + (rowb + q0) * 1024 + h * 64; Ou = Ob + (rowb + q0) * 1024 + h * 64;
        K0 = CK + (size_t)((b * 4 + l) * PAST) * 256 + kvh * 64; V0 = CV + (size_t)((b * 4 + l) * PAST) * 256 + kvh * 64; n0 = PAST / 128;
        int klo = 0, khi = LSEQ; if (!full) { klo = q0 - 128 < 0 ? 0 : q0 - 128; khi = q0 + 384 > LSEQ ? LSEQ : q0 + 384; }
        n1 = (khi - klo) / 128; K1 = Kb + (rowb + klo) * 256 + kvh * 64; V1 = Vb + (rowb + klo) * 256 + kvh * 64; qrel0 = q0 - klo; win = !full;
    } else { const int v = u - 2048; const int b = v >> 4; h = v & 15; const int kvh = h >> 2; const size_t rowb = (size_t)b * CSEQ;
        Qu = Qb + rowb * 1024 + h * 64; Ou = Ob + rowb * 1024 + h * 64; n0 = 0; n1 = CSEQ / 128;
        K1 = Kb + rowb * 256 + kvh * 64; V1 = Vb + rowb * 256 + kvh * 64; K0 = K1; V0 = V1; qrel0 = 0; win = false; }
    sink2 = 0.f; if (!full) sink2 = sinkp[(l >> 1) * 16 + h] * 1.4426950408889634f;
}
__device__ __forceinline__ void attn_phase(LAS unsigned char* lds, const bf16* Qb, bf16* Ob, const bf16* Kb, const bf16* Vb, const bf16* CK, const bf16* CV, const float* sinkp, const float* qg, const float* kg, const unsigned* ckmax,
                                           const int l, const bool full, const int bx, const int G, const int tid) {
    const bool has_sink = !full;
    bool track;
    { float gq = fabsf(qg[tid & 63]), gk = fabsf(kg[tid & 63]);
#pragma unroll
      for (int o = 1; o < 64; o <<= 1) { gq = fmaxf(gq, __shfl_xor(gq, o)); gk = fmaxf(gk, __shfl_xor(gk, o)); }
      const float kn = fmaxf(8.0f * gk, sqrtf(__uint_as_float(ckmax[l])));
      const float bound = 8.0f * gq * kn * (0.125f * 1.4426950408889634f); track = !(bound < 64.0f); track = __builtin_amdgcn_readfirstlane((int)track) != 0; }
    const bf16 *Qu, *K0, *V0, *K1, *V1; bf16* Ou; int n0, n1, qrel0; bool win; float sink2;
    attn_decode(bx, l, full, Qb, Ob, Kb, Vb, CK, CV, sinkp, Qu, Ou, K0, V0, n0, K1, V1, n1, qrel0, win, sink2);
    const int lane = tid & 63, r32 = lane & 31, hi = lane >> 5; const int wid = __builtin_amdgcn_readfirstlane(tid >> 6);
    const int lrow = tid >> 3, lch = tid & 7;
    const unsigned kw = lrow * 128 + ((lch ^ ((lrow >> 1) & 7)) * 16);
    const unsigned vw = 16384 + (lch >> 2) * 4096 + (lrow >> 4) * 1024 + (lrow & 15) * 64 + (lch & 3) * 16;
    const size_t goff = (size_t)lrow * 256 + lch * 8;
    const bf16* Qw = Qu + (size_t)(wid * 32 + r32) * 1024;
    bf16x8 qr[4];
#pragma unroll
    for (int d0 = 0; d0 < 4; ++d0) qr[d0] = *(const bf16x8*)(Qw + d0 * 16 + hi * 8);
    v4u kreg[2], vreg[2];
    { const bf16* kp = n0 > 0 ? K0 : K1; const bf16* vp = n0 > 0 ? V0 : V1;
#pragma unroll
      for (int i = 0; i < 2; ++i) { kreg[i] = *(const v4u*)(kp + goff + i * (64 * 256)); vreg[i] = *(const v4u*)(vp + goff + i * (64 * 256)); } }
#pragma unroll
    for (int i = 0; i < 2; ++i) { *(LAS v4u*)(lds + kw + i * 8192) = kreg[i]; *(LAS v4u*)(lds + vw + i * 8192) = vreg[i]; }
    asm volatile("" : "+v"(qr[0]), "+v"(qr[1]), "+v"(qr[2]), "+v"(qr[3]));
    __syncthreads();
    unsigned par = 0u;
    bf16x8 qn[4];
#pragma unroll
    for (int d0 = 0; d0 < 4; ++d0) qn[d0] = qr[d0];
    const unsigned kr = r32 * 128; const int sw = (r32 >> 1) & 7;
    const unsigned vr = 16384 + ((lane >> 4) & 1) * 32 + (lane & 3) * 8 + (4 * hi + ((lane & 15) >> 2)) * 64;
    for (int u = bx; u < 2048 + 512; u += G) {
        const bool has_next = u + G < 2048 + 512;
        const bf16 *nQu = Qu, *nK0 = K0, *nV0 = V0, *nK1 = K1, *nV1 = V1; bf16* nOu = Ou; int nn0 = n0, nn1 = n1, nqrel0 = qrel0; bool nwin = win; float nsink2 = sink2;
        if (has_next) attn_decode(u + G, l, full, Qb, Ob, Kb, Vb, CK, CV, sinkp, nQu, nOu, nK0, nV0, nn0, nK1, nV1, nn1, nqrel0, nwin, nsink2);
        asm volatile("" : "+v"(qn[0]), "+v"(qn[1]), "+v"(qn[2]), "+v"(qn[3]));
#pragma unroll
        for (int d0 = 0; d0 < 4; ++d0) qr[d0] = qn[d0];
        const int NT = n0 + n1;
    float m = 0.f, l = 0.f;
    f32x16 o0, o1;
#pragma unroll
    for (int r = 0; r < 16; ++r) { o0[r] = 0.f; o1[r] = 0.f; }
    for (int t = 0; t < NT; ++t) {
        const unsigned bo = par * 32768u;
        const bool lastt = t + 1 >= NT; const bool more = !lastt || has_next;
        if (more) { const int tn = t + 1; const bf16* kp = tn < n0 ? K0 + (size_t)tn * (128 * 256) : K1 + (size_t)(tn - n0) * (128 * 256); const bf16* vp = tn < n0 ? V0 + (size_t)tn * (128 * 256) : V1 + (size_t)(tn - n0) * (128 * 256);
            if (lastt) { kp = nn0 > 0 ? nK0 : nK1; vp = nn0 > 0 ? nV0 : nV1; }
#pragma unroll
            for (int i = 0; i < 2; ++i) { kreg[i] = *(const v4u*)(kp + goff + i * (64 * 256)); vreg[i] = *(const v4u*)(vp + goff + i * (64 * 256)); } }
        f32x16 p[4];
        {
            bf16x8 kfa[4], kfb[4];
#define LOADK(dst, c) do { _Pragma("unroll") for (int d0 = 0; d0 < 4; ++d0) dst[d0] = *(const LAS bf16x8*)(lds + bo + kr + (c) * 4096 + (unsigned)(((2 * d0 + hi) ^ sw) * 16)); } while (0)
#define MMAK(c, src) do { p[c] = __builtin_amdgcn_mfma_f32_32x32x16_bf16(src[0], qr[0], pinit, 0, 0, 0); _Pragma("unroll") for (int d0 = 1; d0 < 4; ++d0) p[c] = __builtin_amdgcn_mfma_f32_32x32x16_bf16(src[d0], qr[d0], p[c], 0, 0, 0); } while (0)
#define SB() __builtin_amdgcn_sched_barrier(0)
#define QK_ALL() do { LOADK(kfa, 0); SB(); LOADK(kfb, 1); SB(); MMAK(0, kfa); SB(); LOADK(kfa, 2); SB(); MMAK(1, kfb); SB(); LOADK(kfb, 3); SB(); MMAK(2, kfa); SB(); MMAK(3, kfb); SB(); } while (0)
            if (track) { f32x16 pinit; const float negm = -m;
#pragma unroll
                for (int r = 0; r < 16; ++r) pinit[r] = negm;
                QK_ALL(); }
            else { const f32x16 pinit = {0.f, 0.f, 0.f, 0.f, 0.f, 0.f, 0.f, 0.f, 0.f, 0.f, 0.f, 0.f, 0.f, 0.f, 0.f, 0.f};
                QK_ALL(); }
#undef QK_ALL
#undef LOADK
#undef MMAK
        }
        if (lastt && has_next) { const bf16* nQw = nQu + (size_t)(wid * 32 + r32) * 1024;
#pragma unroll
            for (int d0 = 0; d0 < 4; ++d0) qn[d0] = *(const bf16x8*)(nQw + d0 * 16 + hi * 8); }
        if (win && t >= n0) { const int kb = (t - n0) * 128; const int qw = qrel0 + wid * 32;
            if (!((kb + 127 - qw <= 128) && (qw + 31 - kb <= 128))) { const int q = qw + r32;
#pragma unroll
                for (int c = 0; c < 4; ++c)
#pragma unroll
                    for (int r = 0; r < 16; ++r) { const int d = q - (kb + 32 * c + crow(r, hi)); if (d > 128 || d < -128) p[c][r] = -INFINITY; } } }
        if (track) {
        float mx0 = fmaxf(p[0][0], p[1][0]), mx1 = fmaxf(p[2][0], p[3][0]);
#pragma unroll
        for (int r = 1; r < 16; ++r) { mx0 = fmaxf(fmaxf(mx0, p[0][r]), p[1][r]); mx1 = fmaxf(fmaxf(mx1, p[2][r]), p[3][r]); }
        const float mx = xmax32(fmaxf(mx0, mx1));
        if (__builtin_expect(__any(mx > ATT_THR), 0)) {
            const float dl = fmaxf(mx, 0.f); m += dl; const float alpha = __builtin_amdgcn_exp2f(-dl); l *= alpha;
#pragma unroll
            for (int c = 0; c < 4; ++c)
#pragma unroll
                for (int r = 0; r < 16; ++r) p[c][r] -= dl;
#pragma unroll
            for (int r = 0; r < 16; ++r) { o0[r] *= alpha; o1[r] *= alpha; }
        }
        }
        typedef float f32x2_t __attribute__((ext_vector_type(2)));
        f32x2_t ls0 = {0.f, 0.f}, ls1 = {0.f, 0.f}, ls2 = {0.f, 0.f}, ls3 = {0.f, 0.f};
#pragma unroll
        for (int r = 0; r < 16; r += 2) {
            p[0][r] = __builtin_amdgcn_exp2f(p[0][r]); p[0][r + 1] = __builtin_amdgcn_exp2f(p[0][r + 1]); p[1][r] = __builtin_amdgcn_exp2f(p[1][r]); p[1][r + 1] = __builtin_amdgcn_exp2f(p[1][r + 1]);
            p[2][r] = __builtin_amdgcn_exp2f(p[2][r]); p[2][r + 1] = __builtin_amdgcn_exp2f(p[2][r + 1]); p[3][r] = __builtin_amdgcn_exp2f(p[3][r]); p[3][r + 1] = __builtin_amdgcn_exp2f(p[3][r + 1]);
            ls0 += (f32x2_t){p[0][r], p[0][r + 1]}; ls1 += (f32x2_t){p[1][r], p[1][r + 1]}; ls2 += (f32x2_t){p[2][r], p[2][r + 1]}; ls3 += (f32x2_t){p[3][r], p[3][r + 1]}; }
        { const f32x2_t t = (ls0 + ls1) + (ls2 + ls3); l += t.x + t.y; }
        {
            s16x4 va[4], vb[4];
#define LOADV(dst, ks) do { _Pragma("unroll") for (int d0 = 0; d0 < 2; ++d0) { const unsigned va_ = bo + vr + ((ks) >> 2) * 8192 + d0 * 4096 + ((ks) & 3) * 1024; \
                dst[2 * d0] = __builtin_bit_cast(s16x4, __builtin_amdgcn_ds_read_tr16_b64_v4i16((LAS s16x4*)(lds + va_))); \
                dst[2 * d0 + 1] = __builtin_bit_cast(s16x4, __builtin_amdgcn_ds_read_tr16_b64_v4i16((LAS s16x4*)(lds + va_ + 512))); } } while (0)
#define MMAV(ks, src) do { const int c_ = (ks) >> 1, rb_ = ((ks) & 1) * 8; \
                const v4u pwv = (v4u){pg8::cvt_pk_bf16(p[c_][rb_], p[c_][rb_ + 1]), pg8::cvt_pk_bf16(p[c_][rb_ + 2], p[c_][rb_ + 3]), pg8::cvt_pk_bf16(p[c_][rb_ + 4], p[c_][rb_ + 5]), pg8::cvt_pk_bf16(p[c_][rb_ + 6], p[c_][rb_ + 7])}; \
                const bf16x8 pa = __builtin_bit_cast(bf16x8, pwv); \
                const bf16x8 vf0 = (bf16x8){src[0][0], src[0][1], src[0][2], src[0][3], src[1][0], src[1][1], src[1][2], src[1][3]}; \
                const bf16x8 vf1 = (bf16x8){src[2][0], src[2][1], src[2][2], src[2][3], src[3][0], src[3][1], src[3][2], src[3][3]}; \
                o0 = __builtin_amdgcn_mfma_f32_32x32x16_bf16(vf0, pa, o0, 0, 0, 0); o1 = __builtin_amdgcn_mfma_f32_32x32x16_bf16(vf1, pa, o1, 0, 0, 0); } while (0)
            LOADV(va, 0); SB();
            LOADV(vb, 1); SB(); MMAV(0, va); SB();
            LOADV(va, 2); SB(); MMAV(1, vb); SB();
            LOADV(vb, 3); SB(); MMAV(2, va); SB();
            LOADV(va, 4); SB(); MMAV(3, vb); SB();
            LOADV(vb, 5); SB(); MMAV(4, va); SB();
            LOADV(va, 6); SB(); MMAV(5, vb); SB();
            LOADV(vb, 7); SB(); MMAV(6, va); SB();
            MMAV(7, vb); SB();
#undef LOADV
#undef MMAV
#undef SB
        }
        if (more) {
#pragma unroll
            for (int i = 0; i < 2; ++i) { *(LAS v4u*)(lds + (bo ^ 32768u) + kw + i * 8192) = kreg[i]; *(LAS v4u*)(lds + (bo ^ 32768u) + vw + i * 8192) = vreg[i]; } }
        __syncthreads(); par ^= 1u;
    }
    l = xsum32(l);
    if (has_sink) l += __builtin_amdgcn_exp2f(sink2 - m);
    const float inv = 1.0f / l;
    bf16* Ow = Ou + (size_t)(wid * 32 + r32) * 1024 + 4 * hi;
#pragma unroll
    for (int g = 0; g < 4; ++g) {
        v2u w0, w1; w0.x = pg8::cvt_pk_bf16(o0[4 * g] * inv, o0[4 * g + 1] * inv); w0.y = pg8::cvt_pk_bf16(o0[4 * g + 2] * inv, o0[4 * g + 3] * inv);
        w1.x = pg8::cvt_pk_bf16(o1[4 * g] * inv, o1[4 * g + 1] * inv); w1.y = pg8::cvt_pk_bf16(o1[4 * g + 2] * inv, o1[4 * g + 3] * inv);
        *(v2u*)(Ow + 8 * g) = w0; *(v2u*)(Ow + 32 + 8 * g) = w1; }
        Qu = nQu; Ou = nOu; K0 = nK0; V0 = nV0; K1 = nK1; V1 = nV1; n0 = nn0; n1 = nn1; qrel0 = nqrel0; win = nwin; sink2 = nsink2;
    }
}

__device__ __forceinline__ void attn2_decode(int u, int l, bool full, const bf16* Kb, const bf16* Vb, const bf16* CK, const bf16* CV,
                                             size_t& rowbase, int& h0, bool& pair, const bf16*& K0, const bf16*& V0, int& n0, const bf16*& K1, const bf16*& V1, int& n1, int& qrel0, bool& win) {
    if (u < 1024) { const int b = u >> 7, idx = u & 127, xcd = idx & 7, j = (xcd & 1) * 16 + (idx >> 3), kvh = xcd >> 1; h0 = kvh * 4 + (j >> 3); const int q0 = (j & 7) * 512;
        const size_t rowb = (size_t)MP + (size_t)b * LSEQ; rowbase = rowb + q0; pair = false;
        K0 = CK + (size_t)((b * 4 + l) * PAST) * 256 + kvh * 64; V0 = CV + (size_t)((b * 4 + l) * PAST) * 256 + kvh * 64; n0 = PAST / 64;
        int klo = 0, khi = LSEQ; if (!full) { klo = q0 - 128 < 0 ? 0 : q0 - 128; khi = q0 + 640 > LSEQ ? LSEQ : q0 + 640; }
        n1 = (khi - klo) / 64; K1 = Kb + (rowb + klo) * 256 + kvh * 64; V1 = Vb + (rowb + klo) * 256 + kvh * 64; qrel0 = q0 - klo; win = !full;
    } else { const int v = u - 1024, b = v >> 3, hp = v & 7, kvh = hp >> 1; h0 = 2 * hp; pair = true; rowbase = (size_t)b * CSEQ;
        n0 = 0; n1 = CSEQ / 64; K1 = Kb + rowbase * 256 + kvh * 64; V1 = Vb + rowbase * 256 + kvh * 64; K0 = K1; V0 = V1; qrel0 = 0; win = false; }
}
__device__ __forceinline__ void attn_phase2(LAS unsigned char* lds, const bf16* Qb, bf16* Ob, const bf16* Kb, const bf16* Vb, const bf16* CK, const bf16* CV, const float* sinkp, const float* qg, const float* kg, const unsigned* ckmax,
                                            const int l, const bool full, const int bx, const int G, const int tid) {
    const bool has_sink = !full;
    bool track;
    { float gq = fabsf(qg[tid & 63]), gk = fabsf(kg[tid & 63]);
#pragma unroll
      for (int o = 1; o < 64; o <<= 1) { gq = fmaxf(gq, __shfl_xor(gq, o)); gk = fmaxf(gk, __shfl_xor(gk, o)); }
      const float kn = fmaxf(8.0f * gk, sqrtf(__uint_as_float(ckmax[l])));
      const float bound = 8.0f * gq * kn * (0.125f * 1.4426950408889634f); track = !(bound < 64.0f); track = __builtin_amdgcn_readfirstlane((int)track) != 0; }
    const int lane = tid & 63, r32 = lane & 31, hi = lane >> 5; const int wid = __builtin_amdgcn_readfirstlane(tid >> 6);
    const int lrow = tid >> 3, lch = tid & 7;
    const unsigned kw = lrow * 128 + ((lch ^ ((lrow >> 1) & 7)) * 16);
    const unsigned vw = 8192 + (lch >> 2) * 4096 + (lrow >> 4) * 1024 + (lrow & 15) * 64 + (lch & 3) * 16;
    const size_t goff = (size_t)lrow * 256 + lch * 8;
    const unsigned kr = r32 * 128; const int sw = (r32 >> 1) & 7;
    const unsigned vr = 8192 + ((lane >> 4) & 1) * 32 + (lane & 3) * 8 + (4 * hi + ((lane & 15) >> 2)) * 64;
    size_t rowbase; int h0, n0, n1, qrel0; bool pair, win; const bf16 *K0, *V0, *K1, *V1;
    attn2_decode(bx, l, full, Kb, Vb, CK, CV, rowbase, h0, pair, K0, V0, n0, K1, V1, n1, qrel0, win);
    bf16x8 qr[2][4];
    { const int h = pair ? h0 + (wid >> 2) : h0; const int wrow = pair ? (wid & 3) * 64 : wid * 64;
#pragma unroll
      for (int qb = 0; qb < 2; ++qb) { const bf16* Qw = Qb + (rowbase + wrow + qb * 32 + r32) * 1024 + h * 64;
#pragma unroll
        for (int d0 = 0; d0 < 4; ++d0) qr[qb][d0] = *(const bf16x8*)(Qw + d0 * 16 + hi * 8); } }
    v4u kreg, vreg;
    { const bf16* kp = n0 > 0 ? K0 : K1; const bf16* vp = n0 > 0 ? V0 : V1; kreg = *(const v4u*)(kp + goff); vreg = *(const v4u*)(vp + goff); }
    *(LAS v4u*)(lds + kw) = kreg; *(LAS v4u*)(lds + vw) = vreg;
    __syncthreads();
    unsigned par = 0u;
#define A2SB() __builtin_amdgcn_sched_barrier(0)
    for (int u = bx; u < 1024 + 256; u += G) {
        const bool has_next = u + G < 1024 + 256;
        size_t nrowbase = rowbase; int nh0 = h0, nn0 = n0, nn1 = n1, nqrel0 = qrel0; bool npair = pair, nwin = win; const bf16 *nK0 = K0, *nV0 = V0, *nK1 = K1, *nV1 = V1;
        if (has_next) attn2_decode(u + G, l, full, Kb, Vb, CK, CV, nrowbase, nh0, npair, nK0, nV0, nn0, nK1, nV1, nn1, nqrel0, nwin);
        asm volatile("" : "+v"(qr[0][0]), "+v"(qr[0][1]), "+v"(qr[0][2]), "+v"(qr[0][3]), "+v"(qr[1][0]), "+v"(qr[1][1]), "+v"(qr[1][2]), "+v"(qr[1][3]));
        const int NT = n0 + n1;
        const int h = pair ? h0 + (wid >> 2) : h0; const int wrow = pair ? (wid & 3) * 64 : wid * 64;
        float m[2] = {0.f, 0.f}, lsum[2] = {0.f, 0.f};
        f32x16 o[2][2];
#pragma unroll
        for (int qb = 0; qb < 2; ++qb)
#pragma unroll
            for (int r = 0; r < 16; ++r) { o[qb][0][r] = 0.f; o[qb][1][r] = 0.f; }
        auto iter = [&](const int t, auto lt) __attribute__((always_inline)) { constexpr bool LASTT = decltype(lt)::value;
            const unsigned bo = par * 16384u;
            const bool lastt = LASTT; const bool more = !lastt || has_next;
            if (more) { const int tn = t + 1; const bf16* kp = tn < n0 ? K0 + (size_t)tn * (64 * 256) : K1 + (size_t)(tn - n0) * (64 * 256); const bf16* vp = tn < n0 ? V0 + (size_t)tn * (64 * 256) : V1 + (size_t)(tn - n0) * (64 * 256);
                if (lastt) { kp = nn0 > 0 ? nK0 : nK1; vp = nn0 > 0 ? nV0 : nV1; }
                kreg = *(const v4u*)(kp + goff); vreg = *(const v4u*)(vp + goff); }
            bool live = true; int kb = 0; const int qw = qrel0 + wrow;
            if (win && t >= n0) { kb = (t - n0) * 64; live = (kb - (qw + 63) <= 128) && (qw - (kb + 63) <= 128); }
            if (live) {
                f32x16 p[2][2];
                {   bf16x8 kfa[4];
#define A2LOADK(dst, c) do { _Pragma("unroll") for (int d0 = 0; d0 < 4; ++d0) dst[d0] = *(const LAS bf16x8*)(lds + bo + kr + (c) * 4096 + (unsigned)(((2 * d0 + hi) ^ sw) * 16)); } while (0)
#define A2MFMA(c, d0) do { _Pragma("unroll") for (int qb = 0; qb < 2; ++qb) \
                        p[qb][c] = (zeroc && (d0) == 0) ? __builtin_amdgcn_mfma_f32_32x32x16_bf16(kfa[d0], qr[qb][d0], zvec, 0, 0, 0) : __builtin_amdgcn_mfma_f32_32x32x16_bf16(kfa[d0], qr[qb][d0], p[qb][c], 0, 0, 0); } while (0)
#define A2LOADK1(c, d0) kfa[d0] = *(const LAS bf16x8*)(lds + bo + kr + (c) * 4096 + (unsigned)(((2 * (d0) + hi) ^ sw) * 16))
#define A2QK() do { A2LOADK(kfa, 0); A2SB(); \
                        A2MFMA(0, 0); A2LOADK1(1, 0); A2SB(); A2MFMA(0, 1); A2LOADK1(1, 1); A2SB(); A2MFMA(0, 2); A2LOADK1(1, 2); A2SB(); A2MFMA(0, 3); A2LOADK1(1, 3); A2SB(); \
                        A2MFMA(1, 0); A2SB(); A2MFMA(1, 1); A2SB(); A2MFMA(1, 2); A2SB(); A2MFMA(1, 3); A2SB(); } while (0)
                    const f32x16 zvec = {0.f, 0.f, 0.f, 0.f, 0.f, 0.f, 0.f, 0.f, 0.f, 0.f, 0.f, 0.f, 0.f, 0.f, 0.f, 0.f};
                    if (track) { constexpr bool zeroc = false;
#pragma unroll
                        for (int qb = 0; qb < 2; ++qb)
#pragma unroll
                            for (int c = 0; c < 2; ++c)
#pragma unroll
                                for (int r = 0; r < 16; ++r) p[qb][c][r] = -m[qb];
                        A2QK(); }
                    else { constexpr bool zeroc = true; A2QK(); }
#undef A2QK
#undef A2MFMA
#undef A2LOADK1
#undef A2LOADK
                }
                if (LASTT && has_next) { const int nh = npair ? nh0 + (wid >> 2) : nh0; const int nwrow = npair ? (wid & 3) * 64 : wid * 64;
#pragma unroll
                    for (int qb = 0; qb < 2; ++qb) { const bf16* Qw = Qb + (nrowbase + nwrow + qb * 32 + r32) * 1024 + nh * 64;
#pragma unroll
                        for (int d0 = 0; d0 < 4; ++d0) qr[qb][d0] = *(const bf16x8*)(Qw + d0 * 16 + hi * 8); } }
#pragma unroll
                for (int qb = 0; qb < 2; ++qb) {
                    if (win && t >= n0) { const int qwb = qw + qb * 32;
                        if (!((kb + 63 - qwb <= 128) && (qwb + 31 - kb <= 128))) { const int q = qwb + r32;
#pragma unroll
                            for (int c = 0; c < 2; ++c)
#pragma unroll
                                for (int r = 0; r < 16; ++r) { const int d = q - (kb + 32 * c + crow(r, hi)); if (d > 128 || d < -128) p[qb][c][r] = -INFINITY; } } }
                    if (track) {
                        float mx0 = fmaxf(p[qb][0][0], p[qb][1][0]);
#pragma unroll
                        for (int r = 1; r < 16; ++r) mx0 = fmaxf(fmaxf(mx0, p[qb][0][r]), p[qb][1][r]);
                        const float mx = xmax32(mx0);
                        if (__builtin_expect(__any(mx > ATT_THR), 0)) { const float dl = fmaxf(mx, 0.f); m[qb] += dl; const float alpha = __builtin_amdgcn_exp2f(-dl); lsum[qb] *= alpha;
#pragma unroll
                            for (int c = 0; c < 2; ++c)
#pragma unroll
                                for (int r = 0; r < 16; ++r) p[qb][c][r] -= dl;
#pragma unroll
                            for (int r = 0; r < 16; ++r) { o[qb][0][r] *= alpha; o[qb][1][r] *= alpha; } }
                    }
                    typedef float f32x2_t __attribute__((ext_vector_type(2)));
                    f32x2_t s0 = {0.f, 0.f}, s1 = {0.f, 0.f};
#pragma unroll
                    for (int r = 0; r < 16; r += 2) {
                        p[qb][0][r] = __builtin_amdgcn_exp2f(p[qb][0][r]); p[qb][0][r + 1] = __builtin_amdgcn_exp2f(p[qb][0][r + 1]); p[qb][1][r] = __builtin_amdgcn_exp2f(p[qb][1][r]); p[qb][1][r + 1] = __builtin_amdgcn_exp2f(p[qb][1][r + 1]);
                        s0 += (f32x2_t){p[qb][0][r], p[qb][0][r + 1]}; s1 += (f32x2_t){p[qb][1][r], p[qb][1][r + 1]}; }
                    { const f32x2_t tt = s0 + s1; lsum[qb] += tt.x + tt.y; }
                }
                {   s16x4 va[4], vb[4];
#define A2LOADV(dst, ks) do { _Pragma("unroll") for (int d0 = 0; d0 < 2; ++d0) { const unsigned va_ = bo + vr + d0 * 4096 + (ks) * 1024; \
                        dst[2 * d0] = __builtin_bit_cast(s16x4, __builtin_amdgcn_ds_read_tr16_b64_v4i16((LAS s16x4*)(lds + va_))); \
                        dst[2 * d0 + 1] = __builtin_bit_cast(s16x4, __builtin_amdgcn_ds_read_tr16_b64_v4i16((LAS s16x4*)(lds + va_ + 512))); } } while (0)
#define A2MMAV(ks, src) do { const int c_ = (ks) >> 1, rb_ = ((ks) & 1) * 8; \
                        const bf16x8 vf0 = (bf16x8){src[0][0], src[0][1], src[0][2], src[0][3], src[1][0], src[1][1], src[1][2], src[1][3]}; \
                        const bf16x8 vf1 = (bf16x8){src[2][0], src[2][1], src[2][2], src[2][3], src[3][0], src[3][1], src[3][2], src[3][3]}; \
                        _Pragma("unroll") for (int qb = 0; qb < 2; ++qb) { \
                            const v4u pwv = (v4u){pg8::cvt_pk_bf16(p[qb][c_][rb_], p[qb][c_][rb_ + 1]), pg8::cvt_pk_bf16(p[qb][c_][rb_ + 2], p[qb][c_][rb_ + 3]), pg8::cvt_pk_bf16(p[qb][c_][rb_ + 4], p[qb][c_][rb_ + 5]), pg8::cvt_pk_bf16(p[qb][c_][rb_ + 6], p[qb][c_][rb_ + 7])}; \
                            const bf16x8 pa = __builtin_bit_cast(bf16x8, pwv); \
                            o[qb][0] = __builtin_amdgcn_mfma_f32_32x32x16_bf16(vf0, pa, o[qb][0], 0, 0, 0); o[qb][1] = __builtin_amdgcn_mfma_f32_32x32x16_bf16(vf1, pa, o[qb][1], 0, 0, 0); } } while (0)
                    A2LOADV(va, 0); A2SB();
                    A2LOADV(vb, 1); A2SB(); A2MMAV(0, va); A2SB();
                    A2LOADV(va, 2); A2SB(); A2MMAV(1, vb); A2SB();
                    A2LOADV(vb, 3); A2SB(); A2MMAV(2, va); A2SB();
                    A2MMAV(3, vb); A2SB();
#undef A2LOADV
#undef A2MMAV
                }
            }
            else if (LASTT && has_next) {     const int nh = npair ? nh0 + (wid >> 2) : nh0; const int nwrow = npair ? (wid & 3) * 64 : wid * 64;
#pragma unroll
                    for (int qb = 0; qb < 2; ++qb) { const bf16* Qw = Qb + (nrowbase + nwrow + qb * 32 + r32) * 1024 + nh * 64;
#pragma unroll
                        for (int d0 = 0; d0 < 4; ++d0) qr[qb][d0] = *(const bf16x8*)(Qw + d0 * 16 + hi * 8); } }
            if (more) { *(LAS v4u*)(lds + (bo ^ 16384u) + kw) = kreg; *(LAS v4u*)(lds + (bo ^ 16384u) + vw) = vreg; }
            __syncthreads(); par ^= 1u;
        };
        for (int t = 0; t + 1 < NT; ++t) iter(t, std::false_type{});
        iter(NT - 1, std::true_type{});
        float sink2 = 0.f; if (has_sink) sink2 = sinkp[(l >> 1) * 16 + h] * 1.4426950408889634f;
#pragma unroll
        for (int qb = 0; qb < 2; ++qb) {
            float lt = xsum32(lsum[qb]);
            if (has_sink) lt += __builtin_amdgcn_exp2f(sink2 - m[qb]);
            const float inv = 1.0f / lt;
            bf16* Ow = Ob + (rowbase + wrow + qb * 32 + r32) * 1024 + h * 64 + 4 * hi;
#pragma unroll
            for (int g = 0; g < 4; ++g) {
                v2u w0, w1; w0.x = pg8::cvt_pk_bf16(o[qb][0][4 * g] * inv, o[qb][0][4 * g + 1] * inv); w0.y = pg8::cvt_pk_bf16(o[qb][0][4 * g + 2] * inv, o[qb][0][4 * g + 3] * inv);
                w1.x = pg8::cvt_pk_bf16(o[qb][1][4 * g] * inv, o[qb][1][4 * g + 1] * inv); w1.y = pg8::cvt_pk_bf16(o[qb][1][4 * g + 2] * inv, o[qb][1][4 * g + 3] * inv);
                *(v2u*)(Ow + 8 * g) = w0; *(v2u*)(Ow + 32 + 8 * g) = w1; } }
        rowbase = nrowbase; h0 = nh0; pair = npair; K0 = nK0; V0 = nV0; K1 = nK1; V1 = nV1; n0 = nn0; n1 = nn1; qrel0 = nqrel0; win = nwin;
    }
#undef A2SB
}

struct Args { void* p[18]; int ph_lo, ph_hi; };
#define INP(k) ((const float*)a.p[(k) + zz])
__device__ __forceinline__ void prologue_phase(const Args& a, LAS unsigned char* lds, const int G, const int bx) {
    const int zz = 0; const int tid = threadIdx.x, lane = tid & 63; const int wave = __builtin_amdgcn_readfirstlane(tid >> 6); const int gw = bx * 8 + wave, NGW = G * 8;
    unsigned char* ws = (unsigned char*)a.p[17];
    float* mods = (float*)(ws + WS_MODS); float* ropec = (float*)(ws + WS_ROPE); float* ropes = ropec + 1024;
    bf16* CK = (bf16*)(ws + WS_CK); bf16* CV = (bf16*)(ws + WS_CV);
            for (int u = bx; u < DEPTH * 18; u += G) { const int l = u / 18, chunk = u % 18;
                p0_mods_unit(lds, INP(4), INP(5), INP(6) + (size_t)l * DM * NMODS, INP(7) + (size_t)l * NMODS, mods + (size_t)l * 9 * NMODS, chunk, tid); }
            if (bx == G - 1) p0_rope(ropec, ropes, tid);
            LAS float* scr = (LAS float*)(lds + wave * 16384);
            constexpr int I_QKV = 16 * 48, I_O = 16 * 32, I_1 = 16 * 176, I_2 = 44 * 32, I_L = I_QKV + I_O + 2 * I_1 + 2 * I_2;
            for (int it = gw; it < DEPTH * I_L; it += NGW) {
                const int l = it / I_L; int r = it % I_L;
                if (r < I_QKV) { p0_transpose_item(INP(9) + (size_t)l * DM * NQKV, DM, NQKV, (bf16*)(ws + WS_WQKV) + (size_t)l * NQKV * DM, 2, scr, r, lane); continue; } r -= I_QKV;
                if (r < I_O) { p0_transpose_item(INP(10) + (size_t)l * DM * DM, DM, DM, (bf16*)(ws + WS_WO) + (size_t)l * DM * DM, 0, scr, r, lane); continue; } r -= I_O;
                if (r < 2 * I_1) { const int w = r / I_1; r -= w * I_1;
                    p0_transpose_item(INP(14) + (size_t)(l * 2 + w) * DM * 2 * DFF, DM, 2 * DFF, (bf16*)(ws + WS_W1) + (size_t)(l * 2 + w) * 2 * DFF * DM, 1, scr, r, lane); continue; } r -= 2 * I_1;
                { const int w = r / I_2; r -= w * I_2;
                    p0_transpose_item(INP(15) + (size_t)(l * 2 + w) * DFF * DM, DFF, DM, (bf16*)(ws + WS_W2) + (size_t)(l * 2 + w) * DM * DFF, 0, scr, r, lane); }
            }
            { const size_t n8 = (size_t)8 * 4 * 512 * 256 / 8;
                for (size_t i = (size_t)bx * 512 + tid; i < 2 * n8; i += (size_t)G * 512) { const bool isv = i >= n8; const size_t j = isv ? i - n8 : i;
                    const float* src = (isv ? INP(3) : INP(2)) + j * 8; bf16* dst = (isv ? CV : CK) + j * 8;
                    const f32x4 x0 = *(const f32x4*)src, x1 = *(const f32x4*)(src + 4);
                    v4u o; o.x = pk2(x0.x, x0.y); o.y = pk2(x0.z, x0.w); o.z = pk2(x1.x, x1.y); o.w = pk2(x1.z, x1.w); *(v4u*)dst = o;
                    if (!isv) {
                        float ss = (x0.x * x0.x + x0.y * x0.y) + (x0.z * x0.z + x0.w * x0.w) + (x1.x * x1.x + x1.y * x1.y) + (x1.z * x1.z + x1.w * x1.w);
                        ss += __shfl_xor(ss, 1); ss += __shfl_xor(ss, 2); ss += __shfl_xor(ss, 4);
#pragma unroll
                        for (int sh = 8; sh < 64; sh <<= 1) ss = fmaxf(ss, __shfl_xor(ss, sh));
                        if (!(ss >= 0.f)) ss = __builtin_inff();
                        if (lane == 0) atomicMax((unsigned*)(ws + WS_CKMAX) + (int)((j * 8 / (512 * 256)) & 3), __float_as_uint(ss)); } } }
}
__global__ void __launch_bounds__(512, 2) mk_fwd(Args a) {
    extern __shared__ __attribute__((aligned(16))) unsigned char lds_raw[];
    LAS unsigned char* lds = (LAS unsigned char*)lds_raw;
    cg::grid_group grid = cg::this_grid();
    const int G = gridDim.x, bx = blockIdx.x;
    const int NGW = G * 8;

    for (int u = threadIdx.x; u < 64; u += 512) ((LAS unsigned*)(lds + 131072))[u] = 0u;
    __syncthreads();
    XcdBarrier bar = xcd_barrier_post((unsigned*)a.p[17], (volatile LAS unsigned*)(lds + 131072 + 32));
    int ph = a.ph_lo;
    if (ph == 0) { if (PH_PRO) prologue_phase(a, lds, G, bx); ph = 1; if (ph < a.ph_hi) grid.sync(); }
    bool probe_again = false;
    for (; ph < a.ph_hi; ++ph) {
        int tid = threadIdx.x; asm volatile("" : "+v"(tid));
        const int lane = tid & 63; const int wave = __builtin_amdgcn_readfirstlane(tid >> 6); const int gw = bx * 8 + wave;
        int zz = 0; asm volatile("" : "+s"(zz));
        unsigned char* ws = (unsigned char*)a.p[17 + zz];
        float* out = (float*)a.p[16 + zz];
        float* mods = (float*)(ws + WS_MODS);
        float* ropec = (float*)(ws + WS_ROPE); float* ropes = ropec + 1024;
        bf16* XN = (bf16*)(ws + WS_XN); bf16* HB = (bf16*)(ws + WS_H);
        bf16* Qb = (bf16*)(ws + WS_Q); bf16* Kb = (bf16*)(ws + WS_K); bf16* Vb = (bf16*)(ws + WS_V); bf16* Ob = (bf16*)(ws + WS_O);
        bf16* CK = (bf16*)(ws + WS_CK); bf16* CV = (bf16*)(ws + WS_CV);
        {
            const int l = (ph - 1) / 10, sp = (ph - 1) % 10;
            const float* mods_l = mods + (size_t)l * 9 * NMODS;
            if (PH_MODLN && (sp == 0 || sp == 3 || sp == 7)) {
                const int sub = sp == 0 ? 0 : (sp == 3 ? 1 : 2);
                const float* ng = INP(8) + (size_t)(l * 3 + sub) * DM;
                const bool from_in = (l == 0 && sp == 0);
                for (int rep = 0; rep < ((PROBE_DUP & 1) ? 2 : 1); ++rep)
                for (int q4 = gw; q4 < MT / 4; q4 += NGW) { const int m = q4 * 4;
                    const int cond = m < MP ? 0 : 1 + ((m - MP) >> 12);
                    const float* sh = mods_l + (size_t)cond * NMODS + (3 * sub) * DM;
                    if (from_in) { const float* xrow = m < MP ? INP(0) + (size_t)m * DM : INP(1) + (size_t)(m - MP) * DM; modln_rows4(xrow, ng, sh, sh + DM, XN + (size_t)m * DM, lane); }
                    else modln_rows4_bf16((const bf16*)(ws + WS_HB) + (size_t)m * DM, ng, sh, sh + DM, XN + (size_t)m * DM, lane);
                }
            } else if (PH_FFIN && (sp == 1 || sp == 8)) {
                const int w = sp == 1 ? 0 : 1;
                pg8::Gemm g{XN, (const bf16*)(ws + WS_W1) + (size_t)(l * 2 + w) * 2 * DFF * DM, MT, 2 * DFF, DM}; pg8::StaticOrder S; S.init(MT, 2 * DFF, G, bx);
                pg8::EpiSwiglu E{HB};
                for (int rep = 0; rep < ((PROBE_DUP & 2) ? 2 : 1); ++rep)
                pg8::gemm_phase<pg8::EpiSwiglu, pg8::StaticOrder, true, true>(lds, g, S, E, tid);
            } else if (PH_RES && (sp == 2 || sp == 9 || sp == 6)) {
                const bool isff = sp != 6; const int w = sp == 9 ? 1 : 0;
                const bf16* A = isff ? HB : Ob; const int K = isff ? DFF : DM;
                const bf16* Bt = isff ? (const bf16*)(ws + WS_W2) + (size_t)(l * 2 + w) * DM * DFF : (const bf16*)(ws + WS_WO) + (size_t)l * DM * DM;
                pg8::Gemm g{A, Bt, MT, DM, K}; pg8::StaticOrder S; S.init(MT, DM, G, bx);
                const bool from_in = (l == 0 && sp == 2), last = (l == DEPTH - 1 && sp == 9);
                const float* rb0 = from_in ? INP(0) : nullptr; const long long radj = from_in ? (long long)((INP(1) - (size_t)MP * DM) - INP(0)) : 0ll;
                pg8::EpiResid E{rb0, radj, (bf16*)(ws + WS_HB), last ? out : nullptr, mods_l, (sp == 2 ? 2 : (sp == 6 ? 5 : 8)) * DM, isff ? 0.5f : 1.0f};
                pg8::gemm_phase<pg8::EpiResid, pg8::StaticOrder, true, true>(lds, g, S, E, tid);
            } else if (PH_QKV && sp == 4) {
                pg8::Gemm g{XN, (const bf16*)(ws + WS_WQKV) + (size_t)l * NQKV * DM, MT, NQKV, DM}; pg8::StaticOrder S; S.init(MT, NQKV, G, bx);
                pg8::EpiQKV E{Qb, out + OUT_NK + (size_t)l * 65536, INP(11) + l * 64, INP(12) + l * 64, ropec, 0.125f * 1.4426950408889634f};
                for (int rep = 0; rep < ((PROBE_DUP & 8) ? 2 : 1); ++rep)
                pg8::gemm_phase<pg8::EpiQKV, pg8::StaticOrder, true, true>(lds, g, S, E, tid);
            } else if (PH_ATT && sp == 5) {
                const bool full = (l & 1) == 0;
                for (int rep = 0; rep < ((PROBE_DUP & 4) ? 2 : 1); ++rep)
                attn_phase2(lds, Qb, Ob, Kb, Vb, CK, CV, INP(13), INP(11) + l * 64, INP(12) + l * 64, (const unsigned*)(ws + WS_CKMAX), l, full, bx, G, tid);
            }
        }
        if (ph + 1 < a.ph_hi) xcd_barrier(bar);
        if (PROBE_SKIP_RES((ph - 1) % 10)) { if (!probe_again) { probe_again = true; --ph; } else probe_again = false; }
    }
}

extern "C" void kernel_launch(void* const* d_in, const int* in_sizes, int n_in, void* d_out, int out_size, void* d_ws, size_t ws_size, hipStream_t stream) {
    static int grid = 0;
    if (grid == 0) {
        if (n_in != 16 || ws_size < WS_END) { fprintf(stderr, "kernel_launch: unexpected n_in %d / ws %zu\n", n_in, ws_size); grid = -1; return; }
        int dev = 0, cus = 0, per_cu = 0;
        hipGetDevice(&dev); hipDeviceGetAttribute(&cus, hipDeviceAttributeMultiprocessorCount, dev);
        if (hipFuncSetAttribute((const void*)mk_fwd, hipFuncAttributeMaxDynamicSharedMemorySize, LDS_BYTES) != hipSuccess) { fprintf(stderr, "kernel_launch: hipFuncSetAttribute failed\n"); grid = -1; return; }
        if (hipOccupancyMaxActiveBlocksPerMultiprocessor(&per_cu, (const void*)mk_fwd, 512, LDS_BYTES) != hipSuccess || per_cu < 1) { fprintf(stderr, "kernel_launch: occupancy query says %d\n", per_cu); per_cu = 1; }
        (void)hipGetLastError();
        grid = cus * 1;
    }
    if (grid < 0) return;
    if (hipMemsetAsync(d_ws, 0, 16384, stream) != hipSuccess) { fprintf(stderr, "kernel_launch: hipMemsetAsync failed\n"); return; }
    Args a{};
    for (int i = 0; i < 16; ++i) a.p[i] = d_in[i];
    a.p[16] = d_out; a.p[17] = d_ws;
#if MK_N_LAUNCHES == 1
    a.ph_lo = 0; a.ph_hi = NPHASES;
    { void* args[] = {&a}; hipError_t e = hipLaunchCooperativeKernel((const void*)mk_fwd, dim3(grid), dim3(512), args, LDS_BYTES, stream);
      if (e != hipSuccess) fprintf(stderr, "cooperative launch failed: %s (grid %d)\n", hipGetErrorString(e), grid); }
#else
    for (int ph = 0; ph < NPHASES; ++ph) { a.ph_lo = ph; a.ph_hi = ph + 1; void* args[] = {&a};
        hipError_t e = hipLaunchCooperativeKernel((const void*)mk_fwd, dim3(grid), dim3(512), args, LDS_BYTES, stream);
        if (e != hipSuccess) { fprintf(stderr, "launch %d failed: %s\n", ph, hipGetErrorString(e)); break; } }
#endif
}
```
